# Optimizing an MI355X kernel written in HIP

```python
import jax
import jax.numpy as jnp
from jax import lax
import numpy as np

D_MODEL = 1024
BATCH = 4
SEQ = 4096
DEPTH = 2

GRID_W = 64
CTX_LEN = 256
HEAD_DIM = 64
N_Q_HEADS = 8
N_KV_HEADS = 2
ATTN_WIDTH = N_Q_HEADS * HEAD_DIM
KV_WIDTH = 2 * N_KV_HEADS * HEAD_DIM
CONV_CH = D_MODEL - ATTN_WIDTH
CONF_K = 31
ROPE_AXIS_DIM = HEAD_DIM // 2
ROPE_THETA = 10000.0
Q_BLOCK = 128
EVEN_IN = ATTN_WIDTH + KV_WIDTH + 2 * CONV_CH
SC_K = 3
N_EXPERTS = 16
EC_CAPACITY = 2
EXPERT_FF = 1024
N_MOD = 6
EPS = 1e-6
N_EVEN = (DEPTH + 1) // 2
N_ODD = DEPTH // 2

kernel_name = "hybrid_attn_conformer_shortconv_ec_moe_dit"


def rms_norm(x, g):
    xf = x.astype(jnp.float32)
    y = xf * lax.rsqrt(jnp.mean(xf * xf, axis=-1, keepdims=True) + EPS)
    return (y * g.astype(jnp.float32)).astype(x.dtype)


def layer_norm(x, g, b):
    xf = x.astype(jnp.float32)
    mu = jnp.mean(xf, axis=-1, keepdims=True)
    var = jnp.mean(jnp.square(xf - mu), axis=-1, keepdims=True)
    y = (xf - mu) * lax.rsqrt(var + EPS)
    return (y * g.astype(jnp.float32) + b.astype(jnp.float32)).astype(x.dtype)


def ada_mod(cvec, w, b):
    m = jax.nn.silu(cvec) @ w + b
    return m.reshape(cvec.shape[:-1] + (N_MOD, cvec.shape[-1]))


def modulate(xn, shift, scale):
    return xn * (1 + scale) + shift


def axial_rope_tables(n):
    rows = n // GRID_W
    row = jnp.repeat(jnp.arange(rows, dtype=jnp.float32), GRID_W)
    col = jnp.tile(jnp.arange(GRID_W, dtype=jnp.float32), rows)
    inv = ROPE_THETA ** (-jnp.arange(0, ROPE_AXIS_DIM, 2, dtype=jnp.float32) / ROPE_AXIS_DIM)
    ang = jnp.concatenate([row[:, None] * inv, col[:, None] * inv], axis=-1)
    return jnp.cos(ang)[None, :, None, :], jnp.sin(ang)[None, :, None, :]


def apply_rope(x, cos, sin):
    half = x.shape[-1] // 2
    xf = x.astype(jnp.float32)
    x1, x2 = xf[..., :half], xf[..., half:]
    return jnp.concatenate([x1 * cos - x2 * sin, x2 * cos + x1 * sin], axis=-1).astype(x.dtype)


def depthwise_conv(x, w):
    k = w.shape[0]
    return lax.conv_general_dilated(
        x, w[:, None, :].astype(x.dtype), window_strides=(1,), padding=[(k // 2, k // 2)],
        dimension_numbers=("NWC", "WIO", "NWC"), feature_group_count=x.shape[-1])


def split_kv(kv, k_g):
    bsz, n, _ = kv.shape
    half = KV_WIDTH // 2
    k = kv[..., :half].reshape(bsz, n, N_KV_HEADS, HEAD_DIM)
    v = kv[..., half:].reshape(bsz, n, N_KV_HEADS, HEAD_DIM)
    return rms_norm(k, k_g), v


def block_attention(q, k, v):
    bsz, n, hq, hd = q.shape
    grp = hq // N_KV_HEADS
    nb = n // Q_BLOCK
    qb = q.reshape(bsz, nb, Q_BLOCK, N_KV_HEADS, grp, hd).transpose(1, 0, 2, 3, 4, 5)
    scale = HEAD_DIM ** -0.5

    def one_block(qblk):
        s = jnp.einsum("bqkgd,btkd->bkgqt", qblk, k).astype(jnp.float32) * scale
        p = jax.nn.softmax(s, axis=-1).astype(v.dtype)
        return jnp.einsum("bkgqt,btkd->bqkgd", p, v)

    o = lax.map(one_block, qb)
    return o.transpose(1, 0, 2, 3, 4, 5).reshape(bsz, n, hq * hd)


def context_kv(hcn, w_in, k_g):
    return split_kv(hcn @ w_in[:, ATTN_WIDTH:ATTN_WIDTH + KV_WIDTH], k_g)


def even_mixer(hm, w_in, q_g, k_g, conv_w, conv_b, ln_g, ln_b, w_out, rope, kv_prefix):
    bsz, n, _ = hm.shape
    proj = hm @ w_in
    q = rms_norm(proj[..., :ATTN_WIDTH].reshape(bsz, n, N_Q_HEADS, HEAD_DIM), q_g)
    k, v = split_kv(proj[..., ATTN_WIDTH:ATTN_WIDTH + KV_WIDTH], k_g)
    if rope is not None:
        q = apply_rope(q, *rope)
        k = apply_rope(k, *rope)
    own_kv = (k, v)
    if kv_prefix is not None:
        k = jnp.concatenate([kv_prefix[0], k], axis=1)
        v = jnp.concatenate([kv_prefix[1], v], axis=1)
    attn = block_attention(q, k, v)
    c0 = ATTN_WIDTH + KV_WIDTH
    u = proj[..., c0:c0 + CONV_CH]
    gate = proj[..., c0 + CONV_CH:]
    g = u * jax.nn.sigmoid(gate)
    g = depthwise_conv(g, conv_w) + conv_b
    g = jax.nn.silu(layer_norm(g, ln_g, ln_b))
    return jnp.concatenate([attn, g], axis=-1) @ w_out, own_kv


def short_conv_mixer(hm, w_in, conv_w, w_out):
    proj = hm @ w_in
    d = hm.shape[-1]
    b_gate, c_gate, xv = proj[..., :d], proj[..., d:2 * d], proj[..., 2 * d:]
    y = depthwise_conv(c_gate * xv, conv_w)
    return (b_gate * y) @ w_out


def ec_moe(h, w_r, w_gate, w_up, w_down):
    bsz, n, _ = h.shape
    cap = max(1, EC_CAPACITY * n // N_EXPERTS)
    aff = jax.nn.softmax(jnp.einsum("bnd,de->bne", h, w_r).astype(jnp.float32), axis=-1)
    gates, idx = lax.top_k(jnp.swapaxes(aff, 1, 2), cap)
    bidx = jnp.broadcast_to(jnp.arange(bsz)[:, None, None], idx.shape)
    xs = h[bidx, idx]
    hid = jax.nn.silu(jnp.einsum("becd,edf->becf", xs, w_gate)) * jnp.einsum("becd,edf->becf", xs, w_up)
    ys = jnp.einsum("becf,efd->becd", hid, w_down) * gates[..., None].astype(h.dtype)
    return jnp.zeros_like(h).at[bidx, idx].add(ys)


def setup_inputs(seed: int = 0) -> dict:
    key = jax.random.key(seed)
    ks = iter(jax.random.split(key, 32))

    def nrm(shape, s):
        return jax.random.normal(next(ks), shape, jnp.float32) * s

    def gain(shape):
        return 1.0 + nrm(shape, 0.1)

    L, D, E, F = DEPTH, D_MODEL, N_EXPERTS, EXPERT_FF
    return {
        "x": nrm((BATCH, SEQ, D), 1.0),
        "c": nrm((BATCH, D), 1.0),
        "ctx": nrm((BATCH, CTX_LEN, D), 1.0),
        "c_ctx": nrm((D,), 1.0),
        "ada_w": nrm((L, D, N_MOD * D), 0.5 * D ** -0.5),
        "ada_b": nrm((L, N_MOD * D), 0.1),
        "norm1_g": gain((L, D)),
        "norm2_g": gain((L, D)),
        "ev_w_in": nrm((N_EVEN, D, EVEN_IN), D ** -0.5),
        "ev_q_g": gain((N_EVEN, HEAD_DIM)),
        "ev_k_g": gain((N_EVEN, HEAD_DIM)),
        "ev_conv_w": nrm((N_EVEN, CONF_K, CONV_CH), CONF_K ** -0.5),
        "ev_conv_b": nrm((N_EVEN, CONV_CH), 0.02),
        "ev_ln_g": gain((N_EVEN, CONV_CH)),
        "ev_ln_b": nrm((N_EVEN, CONV_CH), 0.02),
        "ev_w_out": nrm((N_EVEN, ATTN_WIDTH + CONV_CH, D), (ATTN_WIDTH + CONV_CH) ** -0.5),
        "sc_w_in": nrm((N_ODD, D, 3 * D), D ** -0.5),
        "sc_conv_w": nrm((N_ODD, SC_K, D), SC_K ** -0.5),
        "sc_w_out": nrm((N_ODD, D, D), D ** -0.5),
        "moe_w_r": nrm((L, D, E), D ** -0.5),
        "moe_w_gate": nrm((L, E, D, F), D ** -0.5),
        "moe_w_up": nrm((L, E, D, F), D ** -0.5),
        "moe_w_down": nrm((L, E, F, D), F ** -0.5),
        "final_g": gain((D,)),
    }


def reference(x, c, ctx, c_ctx, ada_w, ada_b, norm1_g, norm2_g,
              ev_w_in, ev_q_g, ev_k_g, ev_conv_w, ev_conv_b, ev_ln_g, ev_ln_b, ev_w_out,
              sc_w_in, sc_conv_w, sc_w_out,
              moe_w_r, moe_w_gate, moe_w_up, moe_w_down, final_g):
    rope = axial_rope_tables(x.shape[1])
    h, hc = x, ctx
    for i in range(DEPTH):
        is_even = i % 2 == 0
        ctx_later = any(j % 2 == 0 for j in range(i + 1, DEPTH))
        m = ada_mod(c, ada_w[i], ada_b[i])[:, None]
        hn = modulate(rms_norm(h, norm1_g[i]), m[:, :, 0], m[:, :, 1])
        if is_even or ctx_later:
            mc = ada_mod(c_ctx, ada_w[i], ada_b[i])
            hcn = modulate(rms_norm(hc, norm1_g[i]), mc[0], mc[1])
        if is_even:
            e = i // 2
            prm = (ev_w_in[e], ev_q_g[e], ev_k_g[e], ev_conv_w[e], ev_conv_b[e],
                   ev_ln_g[e], ev_ln_b[e], ev_w_out[e])
            if ctx_later:
                ctx_out, kv_ctx = even_mixer(hcn, *prm, None, None)
                hc = hc + mc[2] * ctx_out
            else:
                kv_ctx = context_kv(hcn, ev_w_in[e], ev_k_g[e])
            lat_out, _ = even_mixer(hn, *prm, rope, kv_ctx)
            h = h + m[:, :, 2] * lat_out
        else:
            o = i // 2
            prm = (sc_w_in[o], sc_conv_w[o], sc_w_out[o])
            h = h + m[:, :, 2] * short_conv_mixer(hn, *prm)
            if ctx_later:
                hc = hc + mc[2] * short_conv_mixer(hcn, *prm)
        moe = (moe_w_r[i], moe_w_gate[i], moe_w_up[i], moe_w_down[i])
        h = h + m[:, :, 5] * ec_moe(modulate(rms_norm(h, norm2_g[i]), m[:, :, 3], m[:, :, 4]), *moe)
        if ctx_later:
            hc = hc + mc[5] * ec_moe(modulate(rms_norm(hc, norm2_g[i]), mc[3], mc[4]), *moe)
    return rms_norm(h, final_g)
```

```cpp
#include <hip/hip_runtime.h>
#include <cstdio>
#include <cstdint>
#include <cstring>

namespace nv {
constexpr int D = 1024, NB = 4, S = 4096, CTX = 256, HD = 64, NQ = 8, NKV = 2, AW = 512, KVW = 256, CC = 512, CK = 31, EIN = 1792;
constexpr int NE = 16, CAP = 512, FF = 1024, T = CTX + S, M = NB * S, NMOD = 6, MR = NB * NE * CAP;
constexpr float EPS = 1e-6f;

__device__ __forceinline__ float wsum(float v) {
#pragma unroll
    for (int o = 32; o > 0; o >>= 1) v += __shfl_xor(v, o);
    return v;
}
__device__ __forceinline__ float wmax(float v) {
#pragma unroll
    for (int o = 32; o > 0; o >>= 1) v = fmaxf(v, __shfl_xor(v, o));
    return v;
}
__device__ __forceinline__ float siluf(float x) { return x / (1.f + expf(-x)); }
__device__ __forceinline__ float sigmf(float x) { return 1.f / (1.f + expf(-x)); }

__global__ void __launch_bounds__(256) k_ada(const float* c, const float* cctx, const float* ada_w, const float* ada_b, float* Mod) {
    __shared__ float sv[5][D];
    for (int i = threadIdx.x; i < 5 * D; i += 256) { int v = i / D, k = i % D; float x = v < 4 ? c[v * D + k] : cctx[k]; sv[v][k] = siluf(x); }
    __syncthreads();
    int idx = blockIdx.x * 256 + threadIdx.x; int l = idx / (NMOD * D), n = idx % (NMOD * D);
    const float* w = ada_w + (size_t)l * D * NMOD * D + n;
    float a[5] = {0, 0, 0, 0, 0};
    for (int k = 0; k < D; ++k) { float wv = w[(size_t)k * NMOD * D];
#pragma unroll
        for (int v = 0; v < 5; ++v) a[v] += sv[v][k] * wv; }
    float bb = ada_b[l * NMOD * D + n];
#pragma unroll
    for (int v = 0; v < 5; ++v) Mod[((size_t)l * 5 + v) * NMOD * D + n] = a[v] + bb;
}

__global__ void __launch_bounds__(256) k_normmod(const float* X, const float* g, const float* mod, int shift_idx, int scale_idx, int rpb, int fixed_v, float* out) {
    int row = blockIdx.x; const float* x = X + (size_t)row * D;
    float v[4]; float ss = 0.f;
#pragma unroll
    for (int j = 0; j < 4; ++j) { v[j] = x[threadIdx.x + 256 * j]; ss += v[j] * v[j]; }
    __shared__ float red[4];
    ss = wsum(ss); if ((threadIdx.x & 63) == 0) red[threadIdx.x >> 6] = ss; __syncthreads();
    ss = red[0] + red[1] + red[2] + red[3];
    float rstd = rsqrtf(ss / D + EPS);
    int vv = fixed_v >= 0 ? fixed_v : row / rpb;
#pragma unroll
    for (int j = 0; j < 4; ++j) { int col = threadIdx.x + 256 * j; float y = v[j] * rstd * g[col];
        if (scale_idx >= 0) { const float* mm = mod + (size_t)vv * NMOD * D; y = y * (1.f + mm[scale_idx * D + col]) + mm[shift_idx * D + col]; }
        out[(size_t)row * D + col] = y; }
}

struct GemmP { const float* A; const float* W; float* C; const int* gidx; int Mz, N, K, lda, ldw, ldc; size_t wstride; int zdivW; int arow_per_zb; int zmodB; int pad; };
__global__ void __launch_bounds__(256) k_gemm(GemmP p) {
    __shared__ float As[16][64 + 1], Ws[16][64];
    int z = blockIdx.z; int m0 = blockIdx.y * 64, n0 = blockIdx.x * 64;
    const float* W = p.W + (size_t)(z / p.zdivW) * p.wstride;
    int tx = threadIdx.x & 15, ty = threadIdx.x >> 4;
    float acc[4][4] = {};
    int ar = threadIdx.x >> 2, ak = (threadIdx.x & 3) * 4;
    int arow; { int m = m0 + ar; if (p.gidx) arow = p.gidx[(size_t)z * p.Mz + m] + (z % p.zmodB) * p.arow_per_zb; else arow = z * p.Mz + m; }
    const float* Ap = p.A + (size_t)arow * p.lda + ak;
    int wr = threadIdx.x >> 4, wc = (threadIdx.x & 15) * 4;
    const float* Wp = W + (size_t)wr * p.ldw + n0 + wc;
    for (int k0 = 0; k0 < p.K; k0 += 16) {
        float4 av = *(const float4*)(Ap + k0);
        float4 wv = *(const float4*)(Wp + (size_t)k0 * p.ldw);
        As[ak + 0][ar] = av.x; As[ak + 1][ar] = av.y; As[ak + 2][ar] = av.z; As[ak + 3][ar] = av.w;
        *(float4*)&Ws[wr][wc] = wv;
        __syncthreads();
#pragma unroll
        for (int k = 0; k < 16; ++k) {
            float a[4], b[4];
#pragma unroll
            for (int i = 0; i < 4; ++i) a[i] = As[k][ty * 4 + i];
#pragma unroll
            for (int j = 0; j < 4; ++j) b[j] = Ws[k][tx * 4 + j];
#pragma unroll
            for (int i = 0; i < 4; ++i)
#pragma unroll
                for (int j = 0; j < 4; ++j) acc[i][j] += a[i] * b[j];
        }
        __syncthreads();
    }
    float* C = p.C + ((size_t)z * p.Mz + m0 + ty * 4) * p.ldc + n0 + tx * 4;
#pragma unroll
    for (int i = 0; i < 4; ++i) *(float4*)(C + (size_t)i * p.ldc) = make_float4(acc[i][0], acc[i][1], acc[i][2], acc[i][3]);
}

__global__ void __launch_bounds__(256) k_qkv(const float* proj, int ldp, int kcol, int is_ctx, const float* qg, const float* kg, float* Q, float* Kb, float* Vb) {
    int wid = blockIdx.x * 4 + (threadIdx.x >> 6), lane = threadIdx.x & 63;
    int row = wid / 12, slot = wid % 12;
    int rpb = is_ctx ? CTX : S; int b = row / rpb, t = row % rpb;
    if (is_ctx && slot < 8) return;
    const float* pr = proj + (size_t)row * ldp;
    size_t kvrow = (size_t)b * T + (is_ctx ? 0 : CTX) + t;
    if (slot >= 10) { Vb[kvrow * 128 + (slot - 10) * 64 + lane] = pr[kcol + 128 + (slot - 10) * 64 + lane]; return; }
    float x = slot < 8 ? pr[slot * 64 + lane] : pr[kcol + (slot - 8) * 64 + lane];
    float ss = wsum(x * x); float y = x * rsqrtf(ss / 64.f + EPS) * (slot < 8 ? qg[lane] : kg[lane]);
    if (!is_ctx) {
        int dd = lane & 31; float pos = dd < 16 ? (float)(t / 64) : (float)(t % 64);
        float inv = powf(10000.f, -(float)(2 * (dd & 15)) / 32.f); float ang = pos * inv;
        float cs = cosf(ang), sn = sinf(ang);
        float other = __shfl_xor(y, 32);
        y = lane < 32 ? y * cs - other * sn : y * cs + other * sn;
    }
    if (slot < 8) Q[(size_t)row * 512 + slot * 64 + lane] = y; else Kb[kvrow * 128 + (slot - 8) * 64 + lane] = y;
}

__global__ void __launch_bounds__(64) k_attn(const float* Q, const float* Kb, const float* Vb, float* ZO) {
    __shared__ float qs[4][64]; __shared__ float ps[4][64];
    int lane = threadIdx.x; int q0 = blockIdx.x * 4, hq = blockIdx.y, b = blockIdx.z; int kvh = hq / 4;
    for (int r = 0; r < 4; ++r) qs[r][lane] = Q[((size_t)b * S + q0 + r) * 512 + hq * 64 + lane] * 0.125f;
    __syncthreads();
    float m[4], l[4], o[4];
#pragma unroll
    for (int r = 0; r < 4; ++r) { m[r] = -1e30f; l[r] = 0.f; o[r] = 0.f; }
    const float* Kp = Kb + (size_t)b * T * 128 + kvh * 64; const float* Vp = Vb + (size_t)b * T * 128 + kvh * 64;
    for (int j0 = 0; j0 < T; j0 += 64) {
        const float4* kr = (const float4*)(Kp + (size_t)(j0 + lane) * 128);
        float s[4] = {0, 0, 0, 0};
#pragma unroll
        for (int i = 0; i < 16; ++i) { float4 kv = kr[i];
#pragma unroll
            for (int r = 0; r < 4; ++r) s[r] += qs[r][4 * i] * kv.x + qs[r][4 * i + 1] * kv.y + qs[r][4 * i + 2] * kv.z + qs[r][4 * i + 3] * kv.w; }
        __syncthreads();
#pragma unroll
        for (int r = 0; r < 4; ++r) { float mx = fmaxf(m[r], wmax(s[r])); float pj = expf(s[r] - mx); float al = expf(m[r] - mx);
            l[r] = l[r] * al + wsum(pj); o[r] *= al; m[r] = mx; ps[r][lane] = pj; }
        __syncthreads();
        for (int j = 0; j < 64; ++j) { float vv = Vp[(size_t)(j0 + j) * 128 + lane];
#pragma unroll
            for (int r = 0; r < 4; ++r) o[r] += ps[r][j] * vv; }
    }
#pragma unroll
    for (int r = 0; r < 4; ++r) ZO[((size_t)b * S + q0 + r) * 1024 + hq * 64 + lane] = o[r] / l[r];
}

__global__ void __launch_bounds__(256) k_conv(const float* proj, const float* cw, const float* cb, const float* lg, const float* lb, float* ZO) {
    int row = blockIdx.x, b = row / S, t = row % S; float v[2];
#pragma unroll
    for (int j = 0; j < 2; ++j) { int c = threadIdx.x + 256 * j; float a = cb[c];
        for (int k = 0; k < CK; ++k) { int tt = t + k - 15; if (tt < 0 || tt >= S) continue; const float* pr = proj + ((size_t)b * S + tt) * EIN;
            a += pr[768 + c] * sigmf(pr[1280 + c]) * cw[k * CC + c]; }
        v[j] = a; }
    __shared__ float red[4];
    float s = wsum(v[0] + v[1]); if ((threadIdx.x & 63) == 0) red[threadIdx.x >> 6] = s; __syncthreads();
    float mu = (red[0] + red[1] + red[2] + red[3]) / CC; __syncthreads();
    float d0 = v[0] - mu, d1 = v[1] - mu; s = wsum(d0 * d0 + d1 * d1); if ((threadIdx.x & 63) == 0) red[threadIdx.x >> 6] = s; __syncthreads();
    float rstd = rsqrtf((red[0] + red[1] + red[2] + red[3]) / CC + EPS);
#pragma unroll
    for (int j = 0; j < 2; ++j) { int c = threadIdx.x + 256 * j; float y = (v[j] - mu) * rstd * lg[c] + lb[c]; ZO[(size_t)row * 1024 + 512 + c] = siluf(y); }
}

__global__ void __launch_bounds__(256) k_resid(const float* Hin, const float* T1, const float* mod, int gate_idx, float* H) {
    size_t i = (size_t)blockIdx.x * 256 + threadIdx.x; int row = (int)(i / D), col = (int)(i % D); int b = row / S;
    H[i] = Hin[i] + mod[(size_t)b * NMOD * D + gate_idx * D + col] * T1[i];
}

__global__ void __launch_bounds__(256) k_router(const float* X, const float* wr, float* aff) {
    int row = blockIdx.x * 4 + (threadIdx.x >> 6), lane = threadIdx.x & 63; const float* x = X + (size_t)row * D;
    float a[NE];
#pragma unroll
    for (int e = 0; e < NE; ++e) a[e] = 0.f;
    for (int j = 0; j < 16; ++j) { int col = lane + 64 * j; float xv = x[col]; const float* w = wr + (size_t)col * NE;
#pragma unroll
        for (int e = 0; e < NE; ++e) a[e] += xv * w[e]; }
    float mx = -1e30f;
#pragma unroll
    for (int e = 0; e < NE; ++e) { a[e] = wsum(a[e]); mx = fmaxf(mx, a[e]); }
    float sm = 0.f;
#pragma unroll
    for (int e = 0; e < NE; ++e) { a[e] = expf(a[e] - mx); sm += a[e]; }
    if (lane < NE) { float val = 0.f;
#pragma unroll
        for (int e = 0; e < NE; ++e) if (e == lane) val = a[e];
        aff[(size_t)row * NE + lane] = val / sm; }
}

__global__ void __launch_bounds__(256) k_topk(const float* aff, int* tok, float* gv, int* inv) {
    __shared__ float vals[S];
    int be = blockIdx.y, b = be / NE, e = be % NE;
    for (int i = threadIdx.x; i < S; i += 256) vals[i] = aff[((size_t)b * S + i) * NE + e];
    __syncthreads();
    int t = blockIdx.x * 256 + threadIdx.x; float v = vals[t]; int rank = 0;
    for (int j = 0; j < S; ++j) { float u = vals[j]; rank += (u > v || (u == v && j < t)) ? 1 : 0; }
    if (rank < CAP) { size_t r = (size_t)(e * NB + b) * CAP + rank; tok[r] = t; gv[r] = v; inv[((size_t)b * S + t) * NE + e] = rank; }
    else inv[((size_t)b * S + t) * NE + e] = -1;
}

__global__ void __launch_bounds__(256) k_swiglu(float* G1, const float* U1, size_t n) {
    size_t i = (size_t)blockIdx.x * 256 + threadIdx.x; if (i < n) G1[i] = siluf(G1[i]) * U1[i];
}

__global__ void __launch_bounds__(256) k_combine(const float* Hin, const float* Y, const int* inv, const float* gv, const float* mod, float* H) {
    int row = blockIdx.x, b = row / S;
    float acc[4] = {0, 0, 0, 0};
    for (int e = 0; e < NE; ++e) { int slot = inv[(size_t)row * NE + e]; if (slot < 0) continue; size_t r = (size_t)(e * NB + b) * CAP + slot; float g = gv[r];
#pragma unroll
        for (int j = 0; j < 4; ++j) acc[j] += g * Y[r * D + threadIdx.x + 256 * j]; }
#pragma unroll
    for (int j = 0; j < 4; ++j) { int col = threadIdx.x + 256 * j; size_t i = (size_t)row * D + col; H[i] = Hin[i] + mod[(size_t)b * NMOD * D + 5 * D + col] * acc[j]; }
}

__global__ void __launch_bounds__(256) k_sconv(const float* proj, const float* w, float* Z) {
    size_t i = (size_t)blockIdx.x * 256 + threadIdx.x; int row = (int)(i / D), c = (int)(i % D); int t = row % S;
    const float* pr = proj + (size_t)row * 3072; float y = 0.f;
#pragma unroll
    for (int k = 0; k < 3; ++k) { int tt = t + k - 1; if (tt < 0 || tt >= S) continue; const float* p2 = pr + (ptrdiff_t)(k - 1) * 3072; y += p2[1024 + c] * p2[2048 + c] * w[k * D + c]; }
    Z[i] = pr[c] * y;
}

struct Bufs {
    float *Mod, *XN, *XNC, *PROJ, *PROJC, *Q, *K, *V, *ZO, *T1, *H, *AFF, *GV, *G1, *U1, *Z; int *TOK, *INV; size_t total;
};

inline void gemm(hipStream_t st, const float* A, const float* W, float* C, int Mz, int N, int K, int lda, int ldw, int ldc, int nz = 1, const int* gidx = nullptr, size_t wstride = 0, int zdivW = 1, int arow_per_zb = 0, int zmodB = 1) {
    GemmP p; memset(&p, 0, sizeof(p)); p.A = A; p.W = W; p.C = C; p.gidx = gidx; p.Mz = Mz; p.N = N; p.K = K; p.lda = lda; p.ldw = ldw; p.ldc = ldc; p.wstride = wstride; p.zdivW = zdivW; p.arow_per_zb = arow_per_zb; p.zmodB = zmodB;
    hipLaunchKernelGGL(k_gemm, dim3(N / 64, Mz / 64, nz), dim3(256), 0, st, p);
}

inline void moe(hipStream_t st, const Bufs& b, void* const* d_in, int l) {
    const float* norm2_g = (const float*)d_in[7] + l * D; const float* mod = b.Mod + (size_t)l * 5 * NMOD * D;
    const float* w_r = (const float*)d_in[19] + (size_t)l * D * NE;
    const float* w_gate = (const float*)d_in[20] + (size_t)l * NE * D * FF; const float* w_up = (const float*)d_in[21] + (size_t)l * NE * D * FF; const float* w_down = (const float*)d_in[22] + (size_t)l * NE * FF * D;
    hipLaunchKernelGGL(k_normmod, dim3(M), dim3(256), 0, st, b.H, norm2_g, mod, 3, 4, S, -1, b.XN);
    hipLaunchKernelGGL(k_router, dim3(M / 4), dim3(256), 0, st, b.XN, w_r, b.AFF);
    hipLaunchKernelGGL(k_topk, dim3(S / 256, NB * NE), dim3(256), 0, st, b.AFF, b.TOK, b.GV, b.INV);
    gemm(st, b.XN, w_gate, b.G1, CAP, FF, D, D, FF, FF, NB * NE, b.TOK, (size_t)D * FF, NB, S, NB);
    gemm(st, b.XN, w_up, b.U1, CAP, FF, D, D, FF, FF, NB * NE, b.TOK, (size_t)D * FF, NB, S, NB);
    hipLaunchKernelGGL(k_swiglu, dim3((unsigned)(((size_t)MR * FF + 255) / 256)), dim3(256), 0, st, b.G1, b.U1, (size_t)MR * FF);
    gemm(st, b.G1, w_down, b.U1, CAP, D, FF, FF, D, D, NB * NE, nullptr, (size_t)FF * D, NB);
    hipLaunchKernelGGL(k_combine, dim3(M), dim3(256), 0, st, b.H, b.U1, b.INV, b.GV, mod, b.H);
}

inline Bufs carve(unsigned char* ws) {
    Bufs b; size_t o = 0; auto take = [&](size_t bytes) { unsigned char* p = ws + o; o += (bytes + 255) & ~(size_t)255; return p; };
    b.Mod = (float*)take((size_t)2 * 5 * NMOD * D * 4);
    b.AFF = (float*)take((size_t)M * NE * 4); b.GV = (float*)take((size_t)MR * 4); b.TOK = (int*)take((size_t)MR * 4); b.INV = (int*)take((size_t)M * NE * 4);
    b.XNC = (float*)take((size_t)NB * CTX * D * 4); b.PROJC = (float*)take((size_t)NB * CTX * KVW * 4);
    b.K = (float*)take((size_t)NB * T * 128 * 4); b.V = (float*)take((size_t)NB * T * 128 * 4);
    b.H = (float*)take((size_t)M * D * 4); b.XN = (float*)take((size_t)M * D * 4);
    unsigned char* R = take((size_t)M * EIN * 4 + (size_t)M * 512 * 4 + (size_t)M * D * 4 * 2);
    b.G1 = (float*)R; b.U1 = (float*)(R + (size_t)MR * FF * 4);
    b.PROJ = (float*)R; b.Q = (float*)(R + (size_t)M * EIN * 4); b.ZO = b.Q + (size_t)M * 512; b.T1 = b.ZO + (size_t)M * D;
    b.Z = (float*)(R + (size_t)M * 3072 * 4);
    b.total = o;
    return b;
}
static_assert((size_t)M * 3072 * 4 + (size_t)M * D * 4 <= (size_t)M * EIN * 4 + (size_t)M * 512 * 4 + (size_t)M * D * 4 * 2, "region R layer 1");
static_assert((size_t)MR * FF * 4 * 2 <= (size_t)M * EIN * 4 + (size_t)M * 512 * 4 + (size_t)M * D * 4 * 2, "region R moe");

inline void forward(void* const* d_in, float* d_out, unsigned char* ws, hipStream_t st) {
    Bufs b = carve(ws);
    const float* x = (const float*)d_in[0]; const float* c = (const float*)d_in[1]; const float* ctx = (const float*)d_in[2]; const float* cctx = (const float*)d_in[3];
    hipLaunchKernelGGL(k_ada, dim3(2 * NMOD * D / 256), dim3(256), 0, st, c, cctx, (const float*)d_in[4], (const float*)d_in[5], b.Mod);
    const float* mod0 = b.Mod; const float* w_in = (const float*)d_in[8];
    hipLaunchKernelGGL(k_normmod, dim3(M), dim3(256), 0, st, x, (const float*)d_in[6], mod0, 0, 1, S, -1, b.XN);
    hipLaunchKernelGGL(k_normmod, dim3(NB * CTX), dim3(256), 0, st, ctx, (const float*)d_in[6], mod0, 0, 1, CTX, 4, b.XNC);
    gemm(st, b.XN, w_in, b.PROJ, M, EIN, D, D, EIN, EIN);
    gemm(st, b.XNC, w_in + 512, b.PROJC, NB * CTX, KVW, D, D, EIN, KVW);
    hipLaunchKernelGGL(k_qkv, dim3(M * 12 / 4), dim3(256), 0, st, b.PROJ, EIN, 512, 0, (const float*)d_in[9], (const float*)d_in[10], b.Q, b.K, b.V);
    hipLaunchKernelGGL(k_qkv, dim3(NB * CTX * 12 / 4), dim3(256), 0, st, b.PROJC, KVW, 0, 1, (const float*)d_in[9], (const float*)d_in[10], b.Q, b.K, b.V);
    hipLaunchKernelGGL(k_attn, dim3(S / 4, NQ, NB), dim3(64), 0, st, b.Q, b.K, b.V, b.ZO);
    hipLaunchKernelGGL(k_conv, dim3(M), dim3(256), 0, st, b.PROJ, (const float*)d_in[11], (const float*)d_in[12], (const float*)d_in[13], (const float*)d_in[14], b.ZO);
    gemm(st, b.ZO, (const float*)d_in[15], b.T1, M, D, D, D, D, D);
    hipLaunchKernelGGL(k_resid, dim3(M * D / 256), dim3(256), 0, st, x, b.T1, mod0, 2, b.H);
    moe(st, b, d_in, 0);
    const float* mod1 = b.Mod + (size_t)5 * NMOD * D;
    hipLaunchKernelGGL(k_normmod, dim3(M), dim3(256), 0, st, b.H, (const float*)d_in[6] + D, mod1, 0, 1, S, -1, b.XN);
    gemm(st, b.XN, (const float*)d_in[16], b.PROJ, M, 3 * D, D, D, 3 * D, 3 * D);
    float* Z = b.Z;
    hipLaunchKernelGGL(k_sconv, dim3(M * D / 256), dim3(256), 0, st, b.PROJ, (const float*)d_in[17], Z);
    float* T1b = b.PROJ;
    gemm(st, Z, (const float*)d_in[18], T1b, M, D, D, D, D, D);
    hipLaunchKernelGGL(k_resid, dim3(M * D / 256), dim3(256), 0, st, b.H, T1b, mod1, 2, b.H);
    moe(st, b, d_in, 1);
    hipLaunchKernelGGL(k_normmod, dim3(M), dim3(256), 0, st, b.H, (const float*)d_in[23], mod0, -1, -1, S, -1, d_out);
}
}
extern "C" void kernel_launch(void* const* d_in, const int* in_sizes, int n_in, void* d_out, int out_size, void* d_ws, size_t ws_size, hipStream_t stream) {
    nv::Bufs b = nv::carve((unsigned char*)d_ws);
    if (b.total > ws_size) { fprintf(stderr, "kernel_launch: workspace too small: need %zu have %zu\n", b.total, ws_size); return; }
    nv::forward(d_in, (float*)d_out, (unsigned char*)d_ws, stream);
}
```

```cpp
#include <hip/hip_runtime.h>
#include <hip/hip_cooperative_groups.h>
#include <cstdio>
#include <cstdint>
#include <cstring>
#define MK_COOP_MARK 0
namespace pg8 {
#define PG8_LAS __attribute__((address_space(3)))
typedef unsigned short bf16_t;
typedef short bf16x8 __attribute__((ext_vector_type(8)));
typedef float f32x4 __attribute__((ext_vector_type(4)));
typedef unsigned u32x4 __attribute__((ext_vector_type(4)));
constexpr int BM = 256, BK = 64, HALF = 128, HTB = HALF * BK * 2  , STAGE_BYTES = 8 * HTB, NXCD = 8, WGM = 1;

__host__ __device__ __forceinline__ int lds_byte(int r, int c) { const int st = (r >> 4) * 2 + (c >> 5), rr = r & 15, cc = c & 31, ob = rr * 64 + cc * 2; return st * 1024 + (ob ^ (((ob >> 9) & 1) << 5)); }
__host__ __device__ __forceinline__ void stage_rc(int b, int& R, int& C) { const int st = b / 1024, sb = b % 1024, swz = sb ^ (((sb >> 9) & 1) << 5); R = (st >> 1) * 16 + swz / 64; C = (st & 1) * 32 + (swz % 64) / 2; }
__host__ __device__ __forceinline__ int perm32(int rho) { const int n = rho >> 4, i = rho & 15; return 8 * (i >> 2) + 4 * n + (i & 3); }

struct Unit { int pm, pn; };
struct Gemm { const bf16_t* A; const bf16_t* Bt; int M, N, K; int pm_per_group; size_t group_stride; };

struct StaticOrder {
    int nM, nN, nwg, G, c;
    __host__ __device__ __forceinline__ void init(int M, int N, int G_, int c_) { nM = M / BM; nN = N / BM; nwg = nM * nN; G = G_; c = c_; }
    __host__ __device__ __forceinline__ bool next(int i, Unit& u) const {
        const long L = (long)i * G + c; if (L >= nwg) return false;
        int wgid = (int)L; { const int q = nwg / NXCD, r = nwg % NXCD, xcd = wgid % NXCD, off = wgid / NXCD; wgid = (xcd < r ? xcd * (q + 1) : r * (q + 1) + (xcd - r) * q) + off; }
        const int nig = WGM * nN, gid = wgid / nig, fm = gid * WGM, gsz = (nM - fm) < WGM ? (nM - fm) : WGM;
        u.pm = fm + ((wgid % nig) % gsz); u.pn = (wgid % nig) / gsz; return true;
    }
};
struct OrderL0 {
    StaticOrder so; int nlat;
    __host__ __device__ __forceinline__ void init(int G_, int c_) { so.init(16384, 1792, G_, c_); nlat = so.nwg; }
    __host__ __device__ __forceinline__ bool next(int i, Unit& u) const {
        const long L = (long)i * so.G + so.c;
        if (L < nlat) return so.next(i, u);
        if (L < nlat + 4) { u.pm = 64 + (int)(L - nlat); u.pn = 2; return true; }
        return false;
    }
};

__device__ __forceinline__ unsigned cvt_pk_bf16(float lo, float hi) { unsigned r; asm volatile("v_cvt_pk_bf16_f32 %0, %1, %2" : "=v"(r) : "v"(lo), "v"(hi)); return r; }
__device__ __forceinline__ u32x4 pack8(const f32x4 a, const f32x4 b) { u32x4 w; w.x = cvt_pk_bf16(a[0], a[1]); w.y = cvt_pk_bf16(a[2], a[3]); w.z = cvt_pk_bf16(b[0], b[1]); w.w = cvt_pk_bf16(b[2], b[3]); return w; }
__device__ __forceinline__ float fast_sigmoid(float x) { return __builtin_amdgcn_rcpf(1.0f + __builtin_amdgcn_exp2f(-1.4426950408889634f * x)); }


struct EpiBf16 {
    static constexpr bool PERM = true;
    bf16_t* O; int ldc;
    __device__ __forceinline__ void operator()(const f32x4 (&acc)[2][2][4][2], const Unit& u, int wr, int wc, int fr, int fq) const {
        const int row0 = u.pm * BM + wr * 64 + fr, col0 = u.pn * BM + wc * 32 + 8 * fq;
#pragma unroll
        for (int ai = 0; ai < 2; ++ai)
#pragma unroll
            for (int m = 0; m < 4; ++m) { bf16_t* rowp = O + (size_t)(row0 + ai * HALF + m * 16) * ldc + col0;
#pragma unroll
                for (int bj = 0; bj < 2; ++bj) *(u32x4*)(rowp + bj * HALF) = pack8(acc[ai][bj][m][0], acc[ai][bj][m][1]); }
    }
};
template <int MODE> struct EpiPair {
    static constexpr bool PERM = true;
    bf16_t* O; int ldc; int pn0; bf16_t* Oplain; int ldp;
    __device__ __forceinline__ void operator()(const f32x4 (&acc)[2][2][4][2], const Unit& u, int wr, int wc, int fr, int fq) const {
        const int row0 = u.pm * BM + wr * 64 + fr;
        if (u.pn < pn0) { EpiBf16 e{Oplain, ldp}; e(acc, u, wr, wc, fr, fq); return; }
        const int col0 = (u.pn - pn0) * HALF + wc * 32 + 8 * fq;
#pragma unroll
        for (int ai = 0; ai < 2; ++ai)
#pragma unroll
            for (int m = 0; m < 4; ++m) { f32x4 o[2];
#pragma unroll
                for (int n = 0; n < 2; ++n) { const f32x4 x = acc[ai][0][m][n], y = acc[ai][1][m][n];
#pragma unroll
                    for (int j = 0; j < 4; ++j) { if (MODE == 0) o[n][j] = x[j] * fast_sigmoid(y[j]); else if (MODE == 1) o[n][j] = x[j] * fast_sigmoid(x[j]) * y[j]; else o[n][j] = x[j] * y[j]; } }
                *(u32x4*)(O + (size_t)(row0 + ai * HALF + m * 16) * ldc + col0) = pack8(o[0], o[1]); }
    }
};
struct EpiRes {
    static constexpr bool PERM = false;
    const float* base; float* out; const float* gate; int gstride;
    __device__ __forceinline__ void operator()(const f32x4 (&acc)[2][2][4][2], const Unit& u, int wr, int wc, int fr, int fq) const {
        const int row0 = u.pm * BM + wr * 64 + fr, col0 = u.pn * BM + wc * 32 + 4 * fq; const int b = (u.pm * BM) >> 12;
        f32x4 gv[2][2];
#pragma unroll
        for (int bj = 0; bj < 2; ++bj)
#pragma unroll
            for (int n = 0; n < 2; ++n) gv[bj][n] = *(const f32x4*)(gate + (size_t)b * gstride + col0 + bj * HALF + n * 16);
#pragma unroll
        for (int ai = 0; ai < 2; ++ai) {
            f32x4 pre[4][2][2];
#pragma unroll
            for (int m = 0; m < 4; ++m) { const size_t off = (size_t)(row0 + ai * HALF + m * 16) * 1024 + col0;
#pragma unroll
                for (int bj = 0; bj < 2; ++bj)
#pragma unroll
                    for (int n = 0; n < 2; ++n) pre[m][bj][n] = *(const f32x4*)(base + off + bj * HALF + n * 16); }
            asm volatile("" ::: "memory");
#pragma unroll
            for (int m = 0; m < 4; ++m) { const size_t off = (size_t)(row0 + ai * HALF + m * 16) * 1024 + col0;
#pragma unroll
                for (int bj = 0; bj < 2; ++bj)
#pragma unroll
                    for (int n = 0; n < 2; ++n) *(f32x4*)(out + off + bj * HALF + n * 16) = pre[m][bj][n] + gv[bj][n] * acc[ai][bj][m][n]; }
            asm volatile("" ::: "memory");
        }
    }
};
template <bool BASEB> struct EpiResB {
    static constexpr bool PERM = true;
    const void* base; bf16_t* out; const float* gate; int gstride;
    __device__ __forceinline__ void operator()(const f32x4 (&acc)[2][2][4][2], const Unit& u, int wr, int wc, int fr, int fq) const {
        const int row0 = u.pm * BM + wr * 64 + fr, col0 = u.pn * BM + wc * 32 + 8 * fq; const int b = (u.pm * BM) >> 12;
        f32x4 gv[2][2];
#pragma unroll
        for (int bj = 0; bj < 2; ++bj)
#pragma unroll
            for (int n = 0; n < 2; ++n) gv[bj][n] = *(const f32x4*)(gate + (size_t)b * gstride + col0 + bj * HALF + 4 * n);
#pragma unroll
        for (int ai = 0; ai < 2; ++ai) {
            f32x4 pre[4][2][2]; u32x4 preb[4][2];
#pragma unroll
            for (int m = 0; m < 4; ++m) { const size_t off = (size_t)(row0 + ai * HALF + m * 16) * 1024 + col0;
#pragma unroll
                for (int bj = 0; bj < 2; ++bj) {
                    if (BASEB) preb[m][bj] = *(const u32x4*)((const bf16_t*)base + off + bj * HALF);
                    else { pre[m][bj][0] = *(const f32x4*)((const float*)base + off + bj * HALF); pre[m][bj][1] = *(const f32x4*)((const float*)base + off + bj * HALF + 4); } } }
            asm volatile("" ::: "memory");
#pragma unroll
            for (int m = 0; m < 4; ++m) { const size_t off = (size_t)(row0 + ai * HALF + m * 16) * 1024 + col0;
#pragma unroll
                for (int bj = 0; bj < 2; ++bj) {
                    f32x4 b0, b1;
                    if (BASEB) { const u32x4 w = preb[m][bj]; b0 = (f32x4){__builtin_bit_cast(float, w.x << 16), __builtin_bit_cast(float, w.x & 0xffff0000u), __builtin_bit_cast(float, w.y << 16), __builtin_bit_cast(float, w.y & 0xffff0000u)};
                        b1 = (f32x4){__builtin_bit_cast(float, w.z << 16), __builtin_bit_cast(float, w.z & 0xffff0000u), __builtin_bit_cast(float, w.w << 16), __builtin_bit_cast(float, w.w & 0xffff0000u)}; }
                    else { b0 = pre[m][bj][0]; b1 = pre[m][bj][1]; }
                    *(u32x4*)(out + off + bj * HALF) = pack8(b0 + gv[bj][0] * acc[ai][bj][m][0], b1 + gv[bj][1] * acc[ai][bj][m][1]); } }
            asm volatile("" ::: "memory");
        }
    }
};
struct EpiL0 {
    static constexpr bool PERM = true;
    bf16_t *Q, *KB, *VB, *G; const float *cosT, *sinT, *qg, *kg; float qscale;
    __device__ __forceinline__ void operator()(const f32x4 (&acc)[2][2][4][2], const Unit& u, int wr, int wc, int fr, int fq) const {
        if (u.pn >= 3) { EpiPair<0> e{G, 512, 3, nullptr, 0}; e(acc, u, wr, wc, fr, fq); return; }
        const bool is_ctx = u.pm >= 64; const bool is_v = (u.pn == 2) && (wc >= 2); const bool is_q = u.pn < 2;
        const int head = is_q ? (4 * u.pn + wc) : (wc & 1);
        const float* gsel = is_q ? qg : kg;
        f32x4 g1[2], g2[2];
#pragma unroll
        for (int n = 0; n < 2; ++n) { g1[n] = *(const f32x4*)(gsel + 8 * fq + 4 * n); g2[n] = *(const f32x4*)(gsel + 32 + 8 * fq + 4 * n); }
#pragma unroll
        for (int ai = 0; ai < 2; ++ai)
#pragma unroll
            for (int m = 0; m < 4; ++m) {
                const int rl = ai * HALF + wr * 64 + m * 16 + fr;
                int t; size_t kvrow, qrow = 0;
                if (!is_ctx) { const int grow = u.pm * BM + rl; const int b = grow >> 12; t = grow & 4095; kvrow = (size_t)b * 4352 + 256 + t; qrow = (size_t)grow; }
                else { const int b = u.pm - 64; t = rl; kvrow = (size_t)b * 4352 + t; }
                f32x4 x1[2] = {acc[ai][0][m][0], acc[ai][0][m][1]}, x2[2] = {acc[ai][1][m][0], acc[ai][1][m][1]};
                if (is_v) { bf16_t* p = VB + kvrow * 128 + head * 64 + 8 * fq; *(u32x4*)p = pack8(x1[0], x1[1]); *(u32x4*)(p + 32) = pack8(x2[0], x2[1]); continue; }
                float ss = 0.f;
#pragma unroll
                for (int n = 0; n < 2; ++n)
#pragma unroll
                    for (int j = 0; j < 4; ++j) ss += x1[n][j] * x1[n][j] + x2[n][j] * x2[n][j];
                { const int ln_ = fr + 16 * fq; ss += __builtin_bit_cast(float, __builtin_amdgcn_ds_bpermute((ln_ ^ 16) << 2, __builtin_bit_cast(int, ss))); ss += __builtin_bit_cast(float, __builtin_amdgcn_ds_bpermute((ln_ ^ 32) << 2, __builtin_bit_cast(int, ss))); }
                const float rstd = __builtin_amdgcn_rsqf(ss * (1.0f / 64.0f) + 1e-6f);
#pragma unroll
                for (int n = 0; n < 2; ++n) { x1[n] = x1[n] * rstd * g1[n]; x2[n] = x2[n] * rstd * g2[n]; }
                if (!is_ctx) {
#pragma unroll
                    for (int n = 0; n < 2; ++n) { const f32x4 cs = *(const f32x4*)(cosT + (size_t)t * 32 + 8 * fq + 4 * n), sn = *(const f32x4*)(sinT + (size_t)t * 32 + 8 * fq + 4 * n);
                        const f32x4 a = x1[n] * cs - x2[n] * sn, b2 = x2[n] * cs + x1[n] * sn; x1[n] = a; x2[n] = b2; }
                }
                if (is_q) { bf16_t* p = Q + qrow * 512 + head * 64 + 8 * fq; *(u32x4*)p = pack8(x1[0] * qscale, x1[1] * qscale); *(u32x4*)(p + 32) = pack8(x2[0] * qscale, x2[1] * qscale); }
                else { bf16_t* p = KB + kvrow * 128 + head * 64 + 8 * fq; *(u32x4*)p = pack8(x1[0], x1[1]); *(u32x4*)(p + 32) = pack8(x2[0], x2[1]); }
            }
    }
};

template <class Epi, class Sched, bool ALIGN_EPI = false, bool GATHER = false>
__device__ __forceinline__ void gemm_phase(PG8_LAS unsigned char* lds, const Gemm g, const Sched& S, const Epi& E, const PG8_LAS unsigned* gl = nullptr) {
    int tid_ = threadIdx.x; asm volatile("" : "+v"(tid_));
    const int tid = tid_, wid = __builtin_amdgcn_readfirstlane(tid >> 6), lane = tid & 63, wr = wid >> 2, wc = wid & 3, fr = lane & 15, fq = lane >> 4;
    const int K = g.K, nt = K / BK;
    const size_t kstep = (size_t)(BK * 2);
    const size_t hstep = (size_t)HALF * K * 2;
    const size_t tstep = 2 * hstep;
    unsigned voffB[2], vC0[2], vC1[2], vN0[2], vN1[2]; int gR[2]; unsigned gC[2];
#pragma unroll
    for (int i = 0; i < 2; ++i) { int R, C; stage_rc(tid * 16 + i * 8192, R, C); const int Rb = Epi::PERM ? ((R & ~31) + perm32(R & 31)) : R;
        voffB[i] = (unsigned)(Rb * K + C) * 2u; gR[i] = R; gC[i] = (unsigned)C * 2u;
        vC0[i] = (unsigned)(R * K + C) * 2u; vC1[i] = vC0[i] + (unsigned)hstep; vN0[i] = vC0[i]; vN1[i] = vC1[i]; }
    const unsigned ldsw = (unsigned)wid * 1024u;
    const int aoff = lds_byte(wr * 64 + fr, fq * 8), boff = lds_byte(wc * 32 + fr, fq * 8);
#define PG8_SA(b, h) (((b) * 2 + (h)) * HTB)
#define PG8_SB(b, h) ((4 + (b) * 2 + (h)) * HTB)
#define PG8_STAGE(bufoff, gbase, voff) do { _Pragma("unroll") for (int _i = 0; _i < 2; ++_i) \
        __builtin_amdgcn_global_load_lds((const unsigned*)((const char*)(gbase) + (voff)[_i]), (PG8_LAS unsigned*)(lds + (bufoff) + ldsw + _i * 8192), 16, 0, 0); } while (0)
#define PG8_LDA(dst, b, h) do { _Pragma("unroll") for (int m = 0; m < 4; ++m) _Pragma("unroll") for (int k = 0; k < 2; ++k) dst[m][k] = *(const PG8_LAS bf16x8*)(lds + PG8_SA(b, h) + aoff + m * 2048 + k * 1024); } while (0)
#define PG8_LDB(dst, b, h) do { _Pragma("unroll") for (int n = 0; n < 2; ++n) _Pragma("unroll") for (int k = 0; k < 2; ++k) dst[n][k] = *(const PG8_LAS bf16x8*)(lds + PG8_SB(b, h) + boff + n * 2048 + k * 1024); } while (0)
#define PG8_MMA(ai, bj, At, Bt) do { __builtin_amdgcn_s_setprio(1); _Pragma("unroll") for (int m = 0; m < 4; ++m) _Pragma("unroll") for (int n = 0; n < 2; ++n) _Pragma("unroll") for (int k = 0; k < 2; ++k) \
        acc[ai][bj][m][n] = __builtin_amdgcn_mfma_f32_16x16x32_bf16(Bt[n][k], At[m][k], acc[ai][bj][m][n], 0, 0, 0); __builtin_amdgcn_s_setprio(0); } while (0)
#define PG8_WAIT_V(n) asm volatile("s_waitcnt vmcnt(" #n ")" ::: "memory")
#define PG8_WAIT_L(n) asm volatile("s_waitcnt lgkmcnt(" #n ")" ::: "memory")
#define PG8_BAR __builtin_amdgcn_s_barrier()
#define PG8_SCHED __builtin_amdgcn_sched_barrier(0)
#define PG8_GLOAD(d0, d1, u_) do { _Pragma("unroll") for (int _i = 0; _i < 2; ++_i) { d0[_i] = gl[(u_) * 256 + gR[_i]] + gC[_i]; d1[_i] = gl[(u_) * 256 + HALF + gR[_i]] + gC[_i]; } } while (0)
#define PG8_APTR(u_) (GATHER ? (const char*)g.A : (const char*)g.A + (size_t)(u_).pm * tstep)
#define PG8_BPTR(u_) ((const char*)g.Bt + (size_t)((u_).pm / g.pm_per_group) * g.group_stride + (size_t)(u_).pn * tstep)
    Unit cur, nxt; int ui = 0;
    if (!S.next(0, cur)) return;
    f32x4 acc[2][2][4][2];
#pragma unroll
    for (int a = 0; a < 2; ++a)
#pragma unroll
        for (int b = 0; b < 2; ++b)
#pragma unroll
            for (int m = 0; m < 4; ++m)
#pragma unroll
                for (int n = 0; n < 2; ++n) acc[a][b][m][n] = (f32x4){0.f, 0.f, 0.f, 0.f};
    bf16x8 At[4][2], B0[2][2], B1[2][2];
    const char* cA = PG8_APTR(cur); const char* cB = PG8_BPTR(cur);
    if constexpr (GATHER) { PG8_GLOAD(vC0, vC1, 0); }
    PG8_STAGE(PG8_SB(0, 0), cB, voffB); PG8_STAGE(PG8_SB(0, 1), cB + hstep, voffB); PG8_STAGE(PG8_SA(0, 0), cA, vC0); PG8_STAGE(PG8_SA(0, 1), cA, vC1);
    if (wr == 1) PG8_BAR;
    PG8_WAIT_V(2); PG8_BAR;
    PG8_STAGE(PG8_SB(1, 0), cB + kstep, voffB); PG8_STAGE(PG8_SA(1, 0), cA + kstep, vC0); PG8_STAGE(PG8_SB(1, 1), cB + hstep + kstep, voffB);
    PG8_WAIT_V(6); PG8_BAR;
    for (;;) {
        const bool has_next = S.next(ui + 1, nxt);
        const char* nA = has_next ? PG8_APTR(nxt) : cA; const char* nB = has_next ? PG8_BPTR(nxt) : cB;
        for (int t = 0; t < nt; t += 2) {
            const bool last = (t == nt - 2);
            const char* a1 = cA + (size_t)(t + 1) * kstep;
            const char* a2 = last ? nA : cA + (size_t)(t + 2) * kstep; const char* b2 = last ? nB : cB + (size_t)(t + 2) * kstep;
            const char* a3 = a2 + kstep; const char* b3 = b2 + kstep;
            unsigned vX0[2], vX1[2];
            if constexpr (GATHER) {
                if (last) { if (has_next) { PG8_GLOAD(vN0, vN1, ui + 1); } else { vN0[0] = vC0[0]; vN0[1] = vC0[1]; vN1[0] = vC1[0]; vN1[1] = vC1[1]; } }
                vX0[0] = last ? vN0[0] : vC0[0]; vX0[1] = last ? vN0[1] : vC0[1]; vX1[0] = last ? vN1[0] : vC1[0]; vX1[1] = last ? vN1[1] : vC1[1];
            } else { vX0[0] = vC0[0]; vX0[1] = vC0[1]; vX1[0] = vC1[0]; vX1[1] = vC1[1]; }
            PG8_LDB(B0, 0, 0); PG8_LDB(B1, 0, 1); PG8_SCHED; PG8_LDA(At, 0, 0); PG8_STAGE(PG8_SA(1, 1), a1, vC1);
            PG8_WAIT_V(8); PG8_WAIT_L(0); PG8_BAR; PG8_MMA(0, 0, At, B0); PG8_MMA(0, 1, At, B1); PG8_BAR; PG8_SCHED;
            PG8_LDA(At, 0, 1); PG8_STAGE(PG8_SB(0, 0), b2, voffB); PG8_STAGE(PG8_SB(0, 1), b2 + hstep, voffB); PG8_STAGE(PG8_SA(0, 0), a2, vX0);
            PG8_WAIT_V(8); PG8_WAIT_L(0); PG8_BAR; PG8_MMA(1, 0, At, B0); PG8_MMA(1, 1, At, B1); PG8_BAR; PG8_SCHED;
            PG8_LDB(B0, 1, 0); PG8_LDB(B1, 1, 1); PG8_SCHED; PG8_LDA(At, 1, 0); PG8_STAGE(PG8_SA(0, 1), a2, vX1);
            PG8_WAIT_V(8); PG8_WAIT_L(0); PG8_BAR; PG8_MMA(0, 0, At, B0); PG8_MMA(0, 1, At, B1); PG8_BAR; PG8_SCHED;
            PG8_LDA(At, 1, 1); PG8_STAGE(PG8_SB(1, 0), b3, voffB); PG8_STAGE(PG8_SB(1, 1), b3 + hstep, voffB); PG8_STAGE(PG8_SA(1, 0), a3, vX0);
            PG8_WAIT_V(8); PG8_WAIT_L(0); PG8_BAR; PG8_MMA(1, 0, At, B0); PG8_MMA(1, 1, At, B1); PG8_BAR; PG8_SCHED;
        }
        if constexpr (ALIGN_EPI) { if (wr == 0) PG8_BAR; }
        { int fr_e = fr, fq_e = fq; asm volatile("" : "+v"(fr_e), "+v"(fq_e));
          E(acc, cur, wr, wc, fr_e, fq_e); }
        if (!has_next) break;
#pragma unroll
        for (int a = 0; a < 2; ++a)
#pragma unroll
            for (int b = 0; b < 2; ++b)
#pragma unroll
                for (int m = 0; m < 4; ++m)
#pragma unroll
                    for (int n = 0; n < 2; ++n) acc[a][b][m][n] = (f32x4){0.f, 0.f, 0.f, 0.f};
        cur = nxt; cA = nA; cB = nB; ++ui;
        if constexpr (GATHER) { vC0[0] = vN0[0]; vC0[1] = vN0[1]; vC1[0] = vN1[0]; vC1[1] = vN1[1]; }
        if constexpr (ALIGN_EPI) { if (wr == 1) PG8_BAR; }
    }
    PG8_WAIT_V(0);
    if constexpr (!ALIGN_EPI) { if (wr == 0) PG8_BAR; }
    PG8_BAR;
#undef PG8_SA
#undef PG8_SB
#undef PG8_STAGE
#undef PG8_LDA
#undef PG8_LDB
#undef PG8_MMA
#undef PG8_WAIT_V
#undef PG8_WAIT_L
#undef PG8_BAR
#undef PG8_SCHED
#undef PG8_GLOAD
#undef PG8_APTR
#undef PG8_BPTR
}
}
#include <hip/hip_bf16.h>
namespace attn_body {
using bf16=__hip_bfloat16;
using bf16x8=__attribute__((ext_vector_type(8)))short;
using s16x4=__attribute__((ext_vector_type(4)))short;
using f32x16=__attribute__((ext_vector_type(16)))float;
using u32x4=__attribute__((ext_vector_type(4)))unsigned;
constexpr int D=64,QP=512,KP=128,OP=1024,NKT=68;
constexpr int NW=8,QBLK=32,QB=QBLK*NW,KVBLK=64;
__device__ __forceinline__ int crow(int r,int hi){return (r&3)+8*(r>>2)+4*hi;}
#define SBAR() __builtin_amdgcn_sched_barrier(0)
constexpr int NSLOT=3, SLOTB=8192;
constexpr int LDS_K=0, LDS_V=NSLOT*SLOTB, LDS_WS=2*NSLOT*SLOTB, LDS_OST=LDS_WS+NW*64*4, LDS_BYTES=LDS_OST+NW*4096;
constexpr float C2=0.125f*1.4426950408889634f;
__device__ __forceinline__ void glds16(const void*gsrc,unsigned lds_dst){unsigned keep;
  asm volatile("s_mov_b32 %0, m0\n\ts_mov_b32 m0, %2\n\ts_nop 0\n\tglobal_load_lds_dwordx4 %1, off\n\ts_mov_b32 m0, %0":"=&s"(keep):"v"(gsrc),"s"(lds_dst):"memory");}
__device__ __forceinline__ float max3f(float a,float b,float c){float r;asm("v_max3_f32 %0, %1, %2, %3":"=v"(r):"v"(a),"v"(b),"v"(c));return r;}
__device__ __forceinline__ float max2f(float a,float b){float r;asm("v_max_f32_e32 %0, %1, %2":"=v"(r):"v"(a),"v"(b));return r;}
__device__ __forceinline__ float fadd_s(float a,float b){float r;asm("v_add_f32_e32 %0, %1, %2":"=v"(r):"v"(a),"v"(b));return r;}
__device__ __forceinline__ float fsub_s(float a,float b){float r;asm("v_sub_f32_e32 %0, %1, %2":"=v"(r):"v"(a),"v"(b));return r;}
typedef float f32x2_t __attribute__((ext_vector_type(2))); typedef __bf16 bf16x2_t __attribute__((ext_vector_type(2)));
__device__ __forceinline__ unsigned cvtpk_s(float lo,float hi){f32x2_t v={lo,hi};bf16x2_t b=__builtin_convertvector(v,bf16x2_t);return __builtin_bit_cast(unsigned,b);}
#define WAIT_BAR(N) asm volatile("s_waitcnt vmcnt(" #N ") lgkmcnt(0)\n\ts_barrier":::"memory")

__device__ __forceinline__ void qkt(f32x16&p0,f32x16&p1,const char*Kslot,const bf16x8*qr,const f32x16&negm,int r32,int hi){
  const char*kb=Kslot+hi*1024+r32*16;
  #pragma unroll
  for(int d0=0;d0<4;++d0){
    const bf16x8 b0=*reinterpret_cast<const bf16x8*>(kb+d0*2048);
    const bf16x8 b1=*reinterpret_cast<const bf16x8*>(kb+d0*2048+512);
    if(d0==0){p0=__builtin_amdgcn_mfma_f32_32x32x16_bf16(b0,qr[0],negm,0,0,0);p1=__builtin_amdgcn_mfma_f32_32x32x16_bf16(b1,qr[0],negm,0,0,0);}
    else{p0=__builtin_amdgcn_mfma_f32_32x32x16_bf16(b0,qr[d0],p0,0,0,0);p1=__builtin_amdgcn_mfma_f32_32x32x16_bf16(b1,qr[d0],p1,0,0,0);}}
}
typedef __attribute__((address_space(3))) const char* lds_cptr;
typedef short v4i16_t __attribute__((ext_vector_type(4)));
__device__ __forceinline__ void kload8(bf16x8*kf,lds_cptr kp){
  kf[0]=*(const __attribute__((address_space(3))) bf16x8*)(kp);      kf[1]=*(const __attribute__((address_space(3))) bf16x8*)(kp+512);
  kf[2]=*(const __attribute__((address_space(3))) bf16x8*)(kp+2048); kf[3]=*(const __attribute__((address_space(3))) bf16x8*)(kp+2560);
  kf[4]=*(const __attribute__((address_space(3))) bf16x8*)(kp+4096); kf[5]=*(const __attribute__((address_space(3))) bf16x8*)(kp+4608);
  kf[6]=*(const __attribute__((address_space(3))) bf16x8*)(kp+6144); kf[7]=*(const __attribute__((address_space(3))) bf16x8*)(kp+6656);
}
__device__ __forceinline__ void kload2(bf16x8*kf,lds_cptr kp,int j){ kf[2*j]=*(const __attribute__((address_space(3))) bf16x8*)(kp+j*2048); kf[2*j+1]=*(const __attribute__((address_space(3))) bf16x8*)(kp+j*2048+512); }
__device__ __forceinline__ s16x4 vtr(lds_cptr p){ return __builtin_bit_cast(s16x4,__builtin_amdgcn_ds_read_tr16_b64_v4i16((__attribute__((address_space(3))) v4i16_t*)p)); }
__device__ __forceinline__ float rowmax(const f32x16&p0,const f32x16&p1){
  float a=max3f(p0[0],p0[1],p1[0]),b=max3f(p0[2],p0[3],p1[1]);a=max3f(a,p1[2],p1[3]);
  #pragma unroll
  for(int r=4;r<16;r+=4){a=max3f(a,p0[r],p0[r+1]);b=max3f(b,p0[r+2],p0[r+3]);a=max3f(a,p1[r],p1[r+1]);b=max3f(b,p1[r+2],p1[r+3]);}
  const float m=max2f(a,b);
  auto rr=__builtin_amdgcn_permlane32_swap(__float_as_uint(m),__float_as_uint(m),false,false);
  return max2f(__uint_as_float(rr[0]),__uint_as_float(rr[1]));
}
__device__ __forceinline__ void pv(f32x16*o,int vb,bf16x8 pa0,bf16x8 pa1,bf16x8 pa2,bf16x8 pa3){
  #pragma unroll
  for(int d0=0;d0<2;++d0){s16x4 lo[4],hi[4];
    #pragma unroll
    for(int ks=0;ks<4;++ks){
      asm volatile("ds_read_b64_tr_b16 %0,%1 offset:%c2":"=&v"(lo[ks]):"v"(vb),"i"(d0*4096+ks*1024):"memory");
      asm volatile("ds_read_b64_tr_b16 %0,%1 offset:%c2":"=&v"(hi[ks]):"v"(vb),"i"(d0*4096+ks*1024+512):"memory");}
    asm volatile("s_waitcnt lgkmcnt(0)":::"memory");SBAR();
    #define PK(k) (bf16x8){lo[k][0],lo[k][1],lo[k][2],lo[k][3],hi[k][0],hi[k][1],hi[k][2],hi[k][3]}
    o[d0]=__builtin_amdgcn_mfma_f32_32x32x16_bf16(pa0,PK(0),o[d0],0,0,0);
    o[d0]=__builtin_amdgcn_mfma_f32_32x32x16_bf16(pa1,PK(1),o[d0],0,0,0);
    o[d0]=__builtin_amdgcn_mfma_f32_32x32x16_bf16(pa2,PK(2),o[d0],0,0,0);
    o[d0]=__builtin_amdgcn_mfma_f32_32x32x16_bf16(pa3,PK(3),o[d0],0,0,0);
    #undef PK
  }
}

#define ATTN_STORE16(p,v) (*(u32x4*)(p)=(v))
template<int THRL> __device__ __forceinline__ void attn_unit(const bf16*Qu,const bf16*__restrict__ Kh,const bf16*__restrict__ Vh,bf16*Ou,char*shm){
  int tid_=threadIdx.x; asm volatile("":"+v"(tid_)); const int tid=tid_,lane=tid&63,r32=lane&31,hi=lane>>5; const int wid=__builtin_amdgcn_readfirstlane(tid>>6);
  const bf16*Qw=Qu+(long)(wid*QBLK)*QP;
  const unsigned lds0=(unsigned)(uintptr_t)shm;
  float*wsf=(float*)(shm+LDS_WS)+wid*64;
  const bf16*ksrc=Kh+(long)lane*KP+wid*8;
  const bf16*vsrc=Vh+(long)(16*(wid&3)+(lane>>2))*KP+(wid>>2)*32+(lane&3)*8;
  const unsigned kdst=lds0+LDS_K+wid*1024, vdst=lds0+LDS_V+wid*1024;
  #define DMA_K(t,slot) glds16(ksrc+(long)(t)*KVBLK*KP,(unsigned)__builtin_amdgcn_readfirstlane(kdst+(slot)))
  #define DMA_V(t,slot) glds16(vsrc+(long)(t)*KVBLK*KP,(unsigned)__builtin_amdgcn_readfirstlane(vdst+(slot)))
  const int vb0=(int)(lds0+LDS_V)+((lane>>4)&1)*32+(lane&3)*8+(4*hi+((lane&15)>>2))*64;
  const char*Kbase=shm+LDS_K; bf16x8 kf[8];
  const lds_cptr shm3=(lds_cptr)shm; const lds_cptr kp0=shm3+LDS_K+hi*1024+r32*16; const lds_cptr vp0=shm3+LDS_V+((lane>>4)&1)*32+(lane&3)*8+(4*hi+((lane&15)>>2))*64;
  constexpr int NT=NKT;
  DMA_K(0,0);DMA_V(0,0);DMA_K(1,SLOTB);
  bf16x8 qr[4];
  #pragma unroll
  for(int d0=0;d0<4;++d0)qr[d0]=*reinterpret_cast<const bf16x8*>(&Qw[(long)r32*QP+d0*16+hi*8]);
  float mhat=0.f,l_reg=0.f;f32x16 o[2];o[0]=f32x16{};o[1]=f32x16{};f32x16 negm=f32x16{};asm volatile("":"+v"(negm));
  #define CMASK(P0,P1,t) do{}while(0)
  bool resc=false;
  #define START(P0,P1) do{ const float rm=rowmax(P0,P1); resc=false; \
    { const float dl=rm; mhat=fadd_s(mhat,dl); \
      _Pragma("unroll") for(int r=0;r<16;++r){P0[r]=fsub_s(P0[r],dl);P1[r]=fsub_s(P1[r],dl);} \
      _Pragma("unroll") for(int r=0;r<16;++r)negm[r]=-mhat; asm volatile("":"+v"(negm)); } \
    _Pragma("unroll") for(int r=0;r<16;++r)P0[r]=__builtin_amdgcn_exp2f(P0[r]); }while(0)
  #define RESC() do{ if(resc){ asm volatile("s_waitcnt lgkmcnt(0)":::"memory"); \
      _Pragma("unroll") for(int d_=0;d_<2;++d_) _Pragma("unroll") for(int r=0;r<16;++r)o[d_][r]*=wsf[crow(r,hi)]; } }while(0)
  f32x16 pA0,pA1,pB0,pB1;
  int sl_prev=0,sl_cur=0,sl_next=SLOTB;
  #define ROT() do{sl_prev=sl_cur;sl_cur=sl_next;sl_next=(sl_next==(NSLOT-1)*SLOTB)?0:sl_next+SLOTB;}while(0)
  DMA_K(2,2*SLOTB);
  WAIT_BAR(3);
  qkt(pA0,pA1,Kbase,qr,negm,r32,hi);asm volatile("s_nop 15\n\ts_nop 7":"+v"(pA0),"+v"(pA1));CMASK(pA0,pA1,0);
  START(pA0,pA1);
  _Pragma("unroll") for(int r=0;r<16;++r)pA1[r]=__builtin_amdgcn_exp2f(pA1[r]);
  WAIT_BAR(0);
  DMA_K(3,0);DMA_V(1,SLOTB);
  ROT();
  kload8(kf,kp0+sl_cur);
  WAIT_BAR(2);
  s16x4 vlo[8],vhi[8]; u32x4 pw0,pw1,pw2,pw3;
  #define PKW(P,B) cvtpk_s(P[B],P[B+1])
  #define PAF(k) __builtin_bit_cast(bf16x8,pw##k)
  #define VFR(i) (bf16x8){vlo[i][0],vlo[i][1],vlo[i][2],vlo[i][3],vhi[i][0],vhi[i][1],vhi[i][2],vhi[i][3]}
  #define PIN(x) asm volatile("":"+v"(x))
  #define MX3(a,b,c) __builtin_fmaxf(__builtin_fmaxf((a),(b)),(c))
  #define GAPA(MF,A0,A1,A2,A3,W0,W1,PW) do{ MF; sacc+=A0; sacc+=A1; sacc+=A2; sacc+=A3; PIN(sacc); W0; W1; PIN(PW); SBAR(); }while(0)
  #define EX(v) __builtin_amdgcn_exp2f(v)
  #define GAPB(MF,X,B) do{ MF; X[B]=EX(X[B]); X[B+1]=EX(X[B+1]); X[B+2]=EX(X[B+2]); X[B+3]=EX(X[B+3]); PIN(X); SBAR(); }while(0)
  #define VRD(i) do{ vlo[i]=vtr(vp_+(((i)>>2)*4096+((i)&3)*1024)); vhi[i]=vtr(vp_+(((i)>>2)*4096+((i)&3)*1024+512)); }while(0)
  #define KRD(G,j) do{ if(G){ kload2(kf,kp0+sl_next,j); SBAR(); } }while(0)
  #define STEP(C0,C1,P0,P1,t,GK,GV,GL) do{ SBAR(); \
    const lds_cptr vp_=vp0+sl_prev; \
    VRD(0); SBAR(); float sacc=(P0[0]+P0[1]); \
    GAPA(C0=__builtin_amdgcn_mfma_f32_32x32x16_bf16(kf[0],qr[0],negm,0,0,0), P0[2],P0[3],P0[4],P0[5],     pw0[0]=PKW(P0,0), pw0[1]=PKW(P0,2), pw0); \
    VRD(4); SBAR(); GAPA(C1=__builtin_amdgcn_mfma_f32_32x32x16_bf16(kf[1],qr[0],negm,0,0,0), P0[6],P0[7],P0[8],P0[9],     pw0[2]=PKW(P0,4), pw0[3]=PKW(P0,6), pw0); \
    VRD(1); SBAR(); GAPA(C0=__builtin_amdgcn_mfma_f32_32x32x16_bf16(kf[2],qr[1],C0,0,0,0),   P0[10],P0[11],P0[12],P0[13], pw1[0]=PKW(P0,8), pw1[1]=PKW(P0,10), pw1); \
    VRD(5); SBAR(); GAPA(C1=__builtin_amdgcn_mfma_f32_32x32x16_bf16(kf[3],qr[1],C1,0,0,0),   P0[14],P0[15],P1[0],P1[1],   pw1[2]=PKW(P0,12),pw1[3]=PKW(P0,14), pw1); \
    VRD(2); SBAR(); GAPA(C0=__builtin_amdgcn_mfma_f32_32x32x16_bf16(kf[4],qr[2],C0,0,0,0),   P1[2],P1[3],P1[4],P1[5],     pw2[0]=PKW(P1,0), pw2[1]=PKW(P1,2), pw2); \
    VRD(6); SBAR(); GAPA(C1=__builtin_amdgcn_mfma_f32_32x32x16_bf16(kf[5],qr[2],C1,0,0,0),   P1[6],P1[7],P1[8],P1[9],     pw2[2]=PKW(P1,4), pw2[3]=PKW(P1,6), pw2); \
    VRD(3); SBAR(); GAPA(C0=__builtin_amdgcn_mfma_f32_32x32x16_bf16(kf[6],qr[3],C0,0,0,0),   P1[10],P1[11],P1[12],P1[13], pw3[0]=PKW(P1,8), pw3[1]=PKW(P1,10), pw3); \
    VRD(7); SBAR(); GAPA(C1=__builtin_amdgcn_mfma_f32_32x32x16_bf16(kf[7],qr[3],C1,0,0,0),   P1[14],P1[15],0.f,0.f,       pw3[2]=PKW(P1,12),pw3[3]=PKW(P1,14), pw3); \
    l_reg+=sacc; \
    if(GK){DMA_K((t)+3,sl_cur);} if(GV){DMA_V((t)+1,sl_next);} \
    CMASK(C0,C1,t); \
    { float a=MX3(C0[0],C0[1],C1[0]),b=MX3(C0[2],C0[3],C1[1]); a=MX3(a,C1[2],C1[3]); \
      _Pragma("unroll") for(int r=4;r<16;r+=4){a=MX3(a,C0[r],C0[r+1]);b=MX3(b,C0[r+2],C0[r+3]);a=MX3(a,C1[r],C1[r+1]);b=MX3(b,C1[r+2],C1[r+3]);} \
      float rm=__builtin_fmaxf(a,b); { auto rr=__builtin_amdgcn_permlane32_swap(__float_as_uint(rm),__float_as_uint(rm),false,false); rm=__builtin_fmaxf(__uint_as_float(rr[0]),__uint_as_float(rr[1])); } \
      resc=false; \
      if(__builtin_expect(__any(rm>(float)THRL),0)){ const float dl=__builtin_fmaxf(rm,0.f); mhat+=dl; \
        _Pragma("unroll") for(int r=0;r<16;++r){C0[r]-=dl;C1[r]-=dl;} \
        _Pragma("unroll") for(int r=0;r<16;++r)negm[r]=-mhat; asm volatile("":"+v"(negm)); \
        const float f=__builtin_amdgcn_exp2f(-dl); l_reg*=f; if(hi==0)wsf[r32]=f; resc=true; } } \
    SBAR(); \
    GAPB(o[0]=__builtin_amdgcn_mfma_f32_32x32x16_bf16(PAF(0),VFR(0),o[0],0,0,0), C0,0); \
    GAPB(o[1]=__builtin_amdgcn_mfma_f32_32x32x16_bf16(PAF(0),VFR(4),o[1],0,0,0), C0,4); \
    KRD(GL,0); GAPB(o[0]=__builtin_amdgcn_mfma_f32_32x32x16_bf16(PAF(1),VFR(1),o[0],0,0,0), C0,8); \
    KRD(GL,1); GAPB(o[1]=__builtin_amdgcn_mfma_f32_32x32x16_bf16(PAF(1),VFR(5),o[1],0,0,0), C0,12); \
    KRD(GL,2); GAPB(o[0]=__builtin_amdgcn_mfma_f32_32x32x16_bf16(PAF(2),VFR(2),o[0],0,0,0), C1,0); \
    KRD(GL,3); GAPB(o[1]=__builtin_amdgcn_mfma_f32_32x32x16_bf16(PAF(2),VFR(6),o[1],0,0,0), C1,4); \
    GAPB(o[0]=__builtin_amdgcn_mfma_f32_32x32x16_bf16(PAF(3),VFR(3),o[0],0,0,0), C1,8); \
    GAPB(o[1]=__builtin_amdgcn_mfma_f32_32x32x16_bf16(PAF(3),VFR(7),o[1],0,0,0), C1,12); \
    }while(0)
  int t=1;
  #undef CMASK
  #define CMASK(P0,P1,t) do{}while(0)
  for(;t+5<NT;t+=2){
    STEP(pB0,pB1,pA0,pA1,t,true,true,true);     WAIT_BAR(2); RESC(); ROT();
    STEP(pA0,pA1,pB0,pB1,t+1,true,true,true);   WAIT_BAR(2); RESC(); ROT();
  }
  #undef CMASK
  #define CMASK(P0,P1,t) do{}while(0)
  #define ENDW(tt) do{ if((tt)+3<NT){WAIT_BAR(2);} else if((tt)+2<NT){WAIT_BAR(1);} else {WAIT_BAR(0);} }while(0)
  for(;t+1<NT;t+=2){
    STEP(pB0,pB1,pA0,pA1,t,(t+3<NT),(t+1<NT),(t+1<NT));       ENDW(t);   RESC(); ROT();
    STEP(pA0,pA1,pB0,pB1,t+1,(t+4<NT),(t+2<NT),(t+2<NT));     ENDW(t+1); RESC(); ROT();
  }
  STEP(pB0,pB1,pA0,pA1,NT-1,false,false,false); RESC();
  { float sacc=pB0[0]+pB0[1]; _Pragma("unroll") for(int r=2;r<16;++r)sacc+=pB0[r]; _Pragma("unroll") for(int r=0;r<16;++r)sacc+=pB1[r]; l_reg+=sacc;
    pw0=(u32x4){PKW(pB0,0),PKW(pB0,2),PKW(pB0,4),PKW(pB0,6)};pw1=(u32x4){PKW(pB0,8),PKW(pB0,10),PKW(pB0,12),PKW(pB0,14)};pw2=(u32x4){PKW(pB1,0),PKW(pB1,2),PKW(pB1,4),PKW(pB1,6)};pw3=(u32x4){PKW(pB1,8),PKW(pB1,10),PKW(pB1,12),PKW(pB1,14)};
    SBAR(); pv(o,vb0+sl_cur,PAF(0),PAF(1),PAF(2),PAF(3)); }
  #undef PKW
  #undef PAF
  #undef VFR
  #undef PIN
  #undef MX3
  #undef GAPA
  #undef GAPB
  #undef EX
  #undef VRD
  #undef KRD
  #undef STEP
  #undef ENDW
  {auto rr=__builtin_amdgcn_permlane32_swap(__float_as_uint(l_reg),__float_as_uint(l_reg),false,false);l_reg=__uint_as_float(rr[0])+__uint_as_float(rr[1]);}
  if(hi==0)wsf[32+r32]=l_reg;asm volatile("s_waitcnt lgkmcnt(0)":::"memory");
  float rli[16];
  #pragma unroll
  for(int r=0;r<16;++r)rli[r]=__builtin_amdgcn_rcpf(wsf[32+crow(r,hi)]);
  bf16*Ow=Ou+(long)(wid*QBLK)*OP;
  { bf16*stg=(bf16*)(shm+LDS_OST)+wid*2048;
    #pragma unroll
    for(int r=0;r<16;++r){const int orow=crow(r,hi);
      #pragma unroll
      for(int d0=0;d0<2;++d0)stg[orow*64+d0*32+r32]=__float2bfloat16(o[d0][r]*rli[r]);}
    asm volatile("s_waitcnt lgkmcnt(0)":::"memory");
    #pragma unroll
    for(int i=0;i<4;++i){const int row=i*8+(lane>>3),ch=lane&7; const u32x4 v=*(const u32x4*)(stg+row*64+ch*8); ATTN_STORE16(Ow+(long)row*OP+ch*8,v);} }
  asm volatile("s_waitcnt lgkmcnt(0)\n\ts_barrier":::"memory");
  #undef DMA_K
  #undef DMA_V
  #undef CMASK
  #undef START
  #undef RESC
  #undef ROT
}
#undef SBAR
#undef WAIT_BAR
}
constexpr int NWAVES = 8;
constexpr int DM = 1024, NB = 4, SEQ = 4096, CTXL = 256, TKV = 4352, MTOK = 16384, EIN = 1792, NE = 16, CAP = 512, MR = 32768, NMOD6 = 6144;
constexpr float EPSN = 1e-6f;
constexpr int NPHASE = 18;
#ifndef MK_COOP_MARK
#define MK_COOP_MARK 1
#endif
#ifndef MK_COMB4
#define MK_COMB4 1
#endif
#ifndef MK_TPROBE
#define MK_TPROBE 0
#endif
#ifndef MK_PER_PHASE
#define MK_PER_PHASE 0
#endif
#ifndef MK_PH_END
#define MK_PH_END NPHASE
#endif

constexpr size_t MiB = 1u << 20;
constexpr size_t WS_CTL = 0, CTL_ZERO_BYTES = 64 * 1024;
constexpr size_t WS_MOD = 1 * MiB, WS_ROPE = 2 * MiB, WS_AFF = 3 * MiB, WS_INV = 4 * MiB, WS_GV = 5 * MiB, WS_GOFF = 5 * MiB + 256 * 1024;
constexpr size_t WS_WIN = 6 * MiB, WS_WOUT = 10 * MiB, WS_SCIN = 12 * MiB, WS_SCOUT = 18 * MiB, WS_GU = 20 * MiB, WS_DN = 148 * MiB;
constexpr size_t WS_XN = 212 * MiB, WS_KB = 246 * MiB, WS_VB = 251 * MiB, WS_RA = 256 * MiB, WS_H = 320 * MiB, WS_HID = 384 * MiB, WS_END = 448 * MiB;
constexpr size_t RA_Q = 0, RA_G = 16 * MiB, RA_ZO = 32 * MiB, RA_Y = 0, RA_BG = 0, RA_CX = 32 * MiB;
constexpr int CW_BAR = 4096;
constexpr int CW_MODCNT = 7936;
constexpr int CW_POOL = 8192;

constexpr int RING_OFF = 0, RING_BYTES = 131072;
constexpr int LDSCTL_OFF = RING_BYTES, MISC_OFF = LDSCTL_OFF + 320, GL_OFF = LDSCTL_OFF + 1024;
constexpr int LDS_BYTES = 147456;
static_assert(GL_OFF + 4096 <= LDS_BYTES, "LDS map");

#define GAS __attribute__((address_space(1)))
#define LAS __attribute__((address_space(3)))
typedef unsigned short bf16;
typedef unsigned v4u __attribute__((ext_vector_type(4)));
typedef float f32x4 __attribute__((ext_vector_type(4)));
typedef short bf16x8 __attribute__((ext_vector_type(8)));
typedef GAS unsigned gu32;
typedef GAS unsigned long long gu64;
#define RLX_AGENT __ATOMIC_RELAXED, __HIP_MEMORY_SCOPE_AGENT
#define LDS_WAIT() asm volatile("s_waitcnt lgkmcnt(0)" ::: "memory")
#define VM_WAIT() asm volatile("s_waitcnt vmcnt(0)" ::: "memory")
__device__ __forceinline__ unsigned long long rt() { return __builtin_amdgcn_s_memrealtime(); }
__device__ __forceinline__ unsigned f2bf(float f) { unsigned u = __builtin_bit_cast(unsigned, f); return (u + 0x7fffu + ((u >> 16) & 1u)) >> 16; }
__device__ __forceinline__ unsigned pk2(float lo, float hi) { return f2bf(lo) | (f2bf(hi) << 16); }

#define XB_TMO      128
#define XB_XCNT(j)  (256  + 64 * (j))
#define XB_XSUB(j)  (1280 + 64 * (j))
#define XB_XGEN(j)  (2304 + 64 * (j))
#define XB_TOP      3328
#define XB_TOPGEN   3392
#define XCD_BAR_WORDS 3456
#define XB_SPIN_CAP (1u << 18)
#ifndef XB_TOPPOLL
#define XB_TOPPOLL 1
#endif
#ifndef XB_FLAT_REL
#define XB_FLAT_REL 0
#endif
#ifndef XB_EARLY_INV
#define XB_EARLY_INV 1
#endif

__device__ __forceinline__ unsigned xb_ld(unsigned* p)              { return __hip_atomic_load(p, __ATOMIC_RELAXED, __HIP_MEMORY_SCOPE_AGENT); }
__device__ __forceinline__ unsigned xb_add(unsigned* p, unsigned v) { return __hip_atomic_fetch_add(p, v, __ATOMIC_RELAXED, __HIP_MEMORY_SCOPE_AGENT); }
__device__ __forceinline__ unsigned xb_xcc_id() { return (unsigned)__builtin_amdgcn_s_getreg((3 << 11) | 20) & 0xFu; }
#define XB_SPIN(cond, bar) do { unsigned _sp = 0; while (cond) { __builtin_amdgcn_s_sleep(1); \
    if ((++_sp & 255u) == 0u) { if (xb_ld(&(bar)[XB_TMO])) break; if (_sp > XB_SPIN_CAP) { atomicAdd(&(bar)[XB_TMO], 1u); break; } } } } while (0)

struct XcdBarrier {
    unsigned* bar; unsigned x;
    volatile LAS unsigned* st;
};

__device__ __forceinline__ XcdBarrier xcd_barrier_post(unsigned* bar, volatile LAS unsigned* st) {
    XcdBarrier b; b.bar = bar; b.x = xb_xcc_id(); b.st = st;
    if (threadIdx.x == 0) (void)xb_add(&bar[XB_XCNT(b.x)], 1u);
    return b;
}
__device__ __forceinline__ void xcd_barrier_complete(unsigned* bar, unsigned x, unsigned& nloc, unsigned& nx) {
    const unsigned G = gridDim.x * gridDim.y * gridDim.z;
    unsigned sum, cnt, mine, sp = 0u;
    for (;;) {
        sum = 0u; cnt = 0u; mine = 0u;
#pragma unroll
        for (unsigned j = 0; j < 16; ++j) { const unsigned c = xb_ld(&bar[XB_XCNT(j)]); sum += c; cnt += (c > 0u) ? 1u : 0u; mine = (j == x) ? c : mine; }
        if (sum == G) break;
        __builtin_amdgcn_s_sleep(1);
        if ((++sp & 255u) == 0u) { if (xb_ld(&bar[XB_TMO])) break; if (sp > XB_SPIN_CAP) { atomicAdd(&bar[XB_TMO], 1u); break; } }
    }
    nloc = mine > 0u ? mine : 1u; nx = cnt > 0u ? cnt : 1u;
}

__device__ __forceinline__ void xcd_barrier(const XcdBarrier& b) {
    asm volatile("s_waitcnt vmcnt(0)" ::: "memory");
    __syncthreads();
    if (threadIdx.x == 0) {
        unsigned* bar = b.bar;
        __builtin_amdgcn_s_waitcnt(0);
        unsigned nloc = b.st[0], nx = b.st[1];
        if (nloc == 0u) { xcd_barrier_complete(bar, b.x, nloc, nx); b.st[0] = nloc; b.st[1] = nx; }
        const unsigned old = xb_add(&bar[XB_XSUB(b.x)], 1u);
        const unsigned gen = old / nloc;
        if (old + 1u == (gen + 1u) * nloc) {
            __builtin_amdgcn_fence(__ATOMIC_RELEASE, "agent");
            asm volatile("s_waitcnt vmcnt(0)" ::: "memory");
#if XB_TOPPOLL
            (void)xb_add(&bar[XB_TOP], 1u);
            asm volatile("buffer_inv sc1" ::: "memory");
            XB_SPIN(xb_ld(&bar[XB_TOP]) < (gen + 1u) * nx, bar);
            xb_add(&bar[XB_XGEN(b.x)], 1u);
            asm volatile("s_waitcnt vmcnt(0)" ::: "memory");
        } else if (false) {
#endif
            const unsigned og = xb_add(&bar[XB_TOP], 1u);
            const unsigned tg = og / nx;
#if XB_EARLY_INV
            asm volatile("buffer_inv sc1" ::: "memory");
#endif
            if (og + 1u == (tg + 1u) * nx) xb_add(&bar[XB_TOPGEN], 1u);
            else XB_SPIN(xb_ld(&bar[XB_TOPGEN]) == tg, bar);
#if !XB_EARLY_INV
            __builtin_amdgcn_fence(__ATOMIC_ACQUIRE, "agent");
#endif
#if !XB_FLAT_REL
            xb_add(&bar[XB_XGEN(b.x)], 1u);
#endif
            asm volatile("s_waitcnt vmcnt(0)" ::: "memory");
        } else {
#if XB_EARLY_INV
            asm volatile("buffer_inv sc1" ::: "memory");
#if XB_FLAT_REL
            XB_SPIN(xb_ld(&bar[XB_TOPGEN]) == gen, bar);
#else
            XB_SPIN(xb_ld(&bar[XB_XGEN(b.x)]) == gen, bar);
#endif
#else
            XB_SPIN(xb_ld(&bar[XB_XGEN(b.x)]) == gen, bar);
            __builtin_amdgcn_fence(__ATOMIC_ACQUIRE, "agent");
#endif
            asm volatile("s_waitcnt vmcnt(0)" ::: "memory");
        }
    }
    __syncthreads();
}


__device__ __forceinline__ float shx(float v, int o, int lane) { return __builtin_bit_cast(float, __builtin_amdgcn_ds_bpermute((lane ^ o) << 2, __builtin_bit_cast(int, v))); }
__device__ __forceinline__ int shxi(int v, int o, int lane) { return __builtin_amdgcn_ds_bpermute((lane ^ o) << 2, v); }
__device__ __forceinline__ float wave_sum(float v, int  ) {
#define WS_DPP(ctrl, rmask) __builtin_bit_cast(float, __builtin_amdgcn_update_dpp(0, __builtin_bit_cast(int, v), (ctrl), (rmask), 0xF, false))
    v += WS_DPP(0xB1, 0xF); v += WS_DPP(0x4E, 0xF); v += WS_DPP(0x141, 0xF); v += WS_DPP(0x140, 0xF); v += WS_DPP(0x142, 0xA); v += WS_DPP(0x143, 0xC);
#undef WS_DPP
    return __builtin_bit_cast(float, __builtin_amdgcn_readlane(__builtin_bit_cast(int, v), 63));
}
__device__ __forceinline__ int wave_sum_i(int v, int  ) {
#define WS_DPP(ctrl, rmask) __builtin_amdgcn_update_dpp(0, v, (ctrl), (rmask), 0xF, false)
    v += WS_DPP(0xB1, 0xF); v += WS_DPP(0x4E, 0xF); v += WS_DPP(0x141, 0xF); v += WS_DPP(0x140, 0xF); v += WS_DPP(0x142, 0xA); v += WS_DPP(0x143, 0xC);
#undef WS_DPP
    return __builtin_amdgcn_readlane(v, 63);
}
typedef unsigned u32x2 __attribute__((ext_vector_type(2)));
__device__ __forceinline__ float bf_lo(unsigned w) { return __builtin_bit_cast(float, w << 16); }
__device__ __forceinline__ float bf_hi(unsigned w) { return __builtin_bit_cast(float, w & 0xffff0000u); }
__device__ __forceinline__ u32x2 pack4(const f32x4 v) { u32x2 w; w.x = pg8::cvt_pk_bf16(v[0], v[1]); w.y = pg8::cvt_pk_bf16(v[2], v[3]); return w; }
__device__ __forceinline__ f32x4 unpack4(const u32x2 w) { return (f32x4){bf_lo(w.x), bf_hi(w.x), bf_lo(w.y), bf_hi(w.y)}; }
__device__ __forceinline__ float sum4(const f32x4 v) { return (v[0] + v[1]) + (v[2] + v[3]); }
__device__ __forceinline__ float dot4(const f32x4 a, const f32x4 b) { return (a[0] * b[0] + a[1] * b[1]) + (a[2] * b[2] + a[3] * b[3]); }

template <class Fill> __device__ __forceinline__ void xcd_barrier_fill(const XcdBarrier& b, const Fill& fill) {
    asm volatile("s_waitcnt vmcnt(0)" ::: "memory");
    __syncthreads();
    if (threadIdx.x == 0) {
        unsigned* bar = b.bar;
        __builtin_amdgcn_s_waitcnt(0);
        unsigned nloc = b.st[0], nx = b.st[1];
        if (nloc == 0u) { xcd_barrier_complete(bar, b.x, nloc, nx); b.st[0] = nloc; b.st[1] = nx; }
        const unsigned old = xb_add(&bar[XB_XSUB(b.x)], 1u);
        const unsigned gen = old / nloc;
        if (old + 1u == (gen + 1u) * nloc) {
            __builtin_amdgcn_fence(__ATOMIC_RELEASE, "agent");
            asm volatile("s_waitcnt vmcnt(0)" ::: "memory");
            const unsigned og = xb_add(&bar[XB_TOP], 1u);
            const unsigned tg = og / nx;
            if (og + 1u == (tg + 1u) * nx) xb_add(&bar[XB_TOPGEN], 1u);
            else XB_SPIN(xb_ld(&bar[XB_TOPGEN]) == tg, bar);
            __builtin_amdgcn_fence(__ATOMIC_ACQUIRE, "agent");
            xb_add(&bar[XB_XGEN(b.x)], 1u);
            asm volatile("s_waitcnt vmcnt(0)" ::: "memory");
        } else {
            XB_SPIN(xb_ld(&bar[XB_XGEN(b.x)]) == gen, bar);
            __builtin_amdgcn_fence(__ATOMIC_ACQUIRE, "agent");
            asm volatile("s_waitcnt vmcnt(0)" ::: "memory");
        }
    } else if (threadIdx.x >= 64) fill();
    __syncthreads();
}

struct Ctx {
    LAS unsigned char* lds; unsigned char* ws; int tid, lane, wave, vcu, G, bx;
};
__device__ __forceinline__ Ctx fresh(const Ctx& F0) { Ctx F = F0; int t = threadIdx.x; asm volatile("" : "+v"(t)); F.tid = t; F.lane = t & 63; F.wave = __builtin_amdgcn_readfirstlane(t >> 6); return F; }

struct TItem { const float* src; int ldw; bf16* dst; };
__device__ __forceinline__ void titem_load(f32x4 (&r)[8], const TItem& it, int lane) {
#pragma unroll
    for (int i = 0; i < 8; ++i) r[i] = *(const f32x4*)(it.src + (size_t)(8 * (lane >> 3) + i) * it.ldw + 4 * (lane & 7));
}
__device__ __forceinline__ void titem_finish(const f32x4 (&r)[8], const TItem& it, LAS float* scr, int lane) {
    LAS unsigned char* img = (LAS unsigned char*)scr; const int col4 = lane & 7, krow = lane >> 3;
#pragma unroll
    for (int e = 0; e < 4; ++e) { v4u w; w.x = pg8::cvt_pk_bf16(r[0][e], r[1][e]); w.y = pg8::cvt_pk_bf16(r[2][e], r[3][e]); w.z = pg8::cvt_pk_bf16(r[4][e], r[5][e]); w.w = pg8::cvt_pk_bf16(r[6][e], r[7][e]);
        *(LAS v4u*)(img + (4 * col4 + e) * 128 + ((krow ^ col4) << 4)) = w; }
    LDS_WAIT(); asm volatile("" ::: "memory");
    const int c = lane & 7;
#pragma unroll
    for (int j = 0; j < 4; ++j) { const int n = (lane >> 3) + 8 * j; const v4u o = *(const LAS v4u*)(img + n * 128 + ((c ^ ((n >> 2) & 7)) << 4));
        *(GAS v4u*)(it.dst + (size_t)n * 1024 + 8 * c) = o; }
    LDS_WAIT(); asm volatile("" ::: "memory");
}
__device__ __forceinline__ int win_src_col(int g) { const int pn = g >> 3, bj = (g >> 2) & 1, wc = g & 3;
    if (pn < 2) return 64 * (4 * pn + wc) + 32 * bj;
    if (pn == 2) return (wc < 2 ? 512 + 64 * wc : 640 + 64 * (wc - 2)) + 32 * bj;
    return (bj == 0 ? 768 : 1280) + 128 * (pn - 3) + 32 * wc; }
__device__ __forceinline__ int scin_src_col(int g) { const int pn = g >> 3, bj = (g >> 2) & 1, wc = g & 3;
    if (pn < 4) return 32 * g;
    return (bj == 0 ? 1024 : 2048) + 128 * (pn - 4) + 32 * wc; }

constexpr int I_WIN = 16 * 56, I_WOUT = 16 * 32, I_SCIN = 16 * 96, I_SCOUT = 16 * 32, I_SMALL = I_WIN + I_WOUT + I_SCIN + I_SCOUT, I_MOE = 32 * 1536, NITEMS = I_SMALL + I_MOE;
#ifndef MK_BARFILL
#define MK_BARFILL 0
#endif
constexpr int BF_SEAM0 = 3, BF_NSEAM = MK_BARFILL ? 10 : 0, BF_ITEMS = BF_NSEAM * 256 * 7;
constexpr int CHUNK_ITEMS = 64, NCHUNK = (I_MOE - BF_ITEMS) / CHUNK_ITEMS;
static_assert((I_MOE - BF_ITEMS) % CHUNK_ITEMS == 0 && I_MOE - BF_ITEMS > I_MOE / 2, "barrier-filler items all belong to layer 1");
static_assert(I_MOE % CHUNK_ITEMS == 0, "chunks");
template <class AP> __device__ __forceinline__ TItem decode_item(const Ctx& F, AP ap, int it) {
#define in ap->in
    int r = it;
    if (r < I_WIN) { const int kb = r / 56, g = r % 56; return TItem{in[8] + (size_t)kb * 64 * EIN + win_src_col(g), EIN, (bf16*)(F.ws + WS_WIN) + (size_t)g * 32 * 1024 + kb * 64}; } r -= I_WIN;
    if (r < I_WOUT) { const int kb = r / 32, g = r % 32; return TItem{in[15] + (size_t)kb * 64 * 1024 + g * 32, 1024, (bf16*)(F.ws + WS_WOUT) + (size_t)g * 32 * 1024 + kb * 64}; } r -= I_WOUT;
    if (r < I_SCIN) { const int kb = r / 96, g = r % 96; return TItem{in[16] + (size_t)kb * 64 * 3072 + scin_src_col(g), 3072, (bf16*)(F.ws + WS_SCIN) + (size_t)g * 32 * 1024 + kb * 64}; } r -= I_SCIN;
    if (r < I_SCOUT) { const int kb = r / 32, g = r % 32; return TItem{in[18] + (size_t)kb * 64 * 1024 + g * 32, 1024, (bf16*)(F.ws + WS_SCOUT) + (size_t)g * 32 * 1024 + kb * 64}; } r -= I_SCOUT;
    const int le = r / 1536, q = r % 1536, which = q >> 9, q2 = q & 511, kb = q2 >> 5, g = q2 & 31;
    const size_t so = (size_t)le * 1024 * 1024 + (size_t)kb * 64 * 1024 + g * 32;
    if (which == 2) return TItem{in[22] + so, 1024, (bf16*)(F.ws + WS_DN) + (size_t)le * 1024 * 1024 + (size_t)g * 32 * 1024 + kb * 64};
    const int pos = 256 * (g >> 2) + 128 * which + 32 * (g & 3);
    return TItem{(which == 0 ? in[20] : in[21]) + so, 1024, (bf16*)(F.ws + WS_GU) + (size_t)le * 2048 * 1024 + (size_t)pos * 1024 + kb * 64};
#undef in
}
template <class AP> __device__ __forceinline__ void convert_items(const Ctx& F, AP ap, int first, int end, int stride) {
    LAS float* scr = (LAS float*)(F.lds + RING_OFF + F.wave * 16384);
    f32x4 ra[8], rb[8]; TItem A, B;
    int it = first;
    if (it < end) { A = decode_item(F, ap, it); titem_load(ra, A, F.lane); }
    while (it < end) {
        int nx = it + stride;
        if (nx < end) { B = decode_item(F, ap, nx); titem_load(rb, B, F.lane); }
        titem_finish(ra, A, scr, F.lane);
        it = nx; if (it >= end) break;
        nx = it + stride;
        if (nx < end) { A = decode_item(F, ap, nx); titem_load(ra, A, F.lane); }
        titem_finish(rb, B, scr, F.lane);
        it = nx;
    }
}

template <class AP> __device__ __forceinline__ void convert_items8(const Ctx& F, AP ap, int first) {
    LAS float* scr = (LAS float*)(F.lds + RING_OFF + F.wave * 16384);
    f32x4 r0[8], r1[8], r2[8]; TItem a0, a1, a2;
#define CI_LOAD(r, it, k) do { it = decode_item(F, ap, first + (k)); titem_load(r, it, F.lane); } while (0)
    CI_LOAD(r0, a0, 0); CI_LOAD(r1, a1, 1); CI_LOAD(r2, a2, 2);
    titem_finish(r0, a0, scr, F.lane); CI_LOAD(r0, a0, 3);
    titem_finish(r1, a1, scr, F.lane); CI_LOAD(r1, a1, 4);
    titem_finish(r2, a2, scr, F.lane); CI_LOAD(r2, a2, 5);
    titem_finish(r0, a0, scr, F.lane); CI_LOAD(r0, a0, 6);
    titem_finish(r1, a1, scr, F.lane); CI_LOAD(r1, a1, 7);
    titem_finish(r2, a2, scr, F.lane); titem_finish(r0, a0, scr, F.lane); titem_finish(r1, a1, scr, F.lane);
#undef CI_LOAD
}

#ifndef MK_CVD
#define MK_CVD 5
#endif
template <class AP> __device__ __forceinline__ void convert_items8d(const Ctx& F, AP ap, int first) {
    LAS float* scr = (LAS float*)(F.lds + RING_OFF + F.wave * 16384);
    f32x4 r0[8], r1[8], r2[8], r3[8]; TItem a0, a1, a2, a3;
#define CI_LOAD(r, it, k) do { it = decode_item(F, ap, first + (k)); titem_load(r, it, F.lane); } while (0)
#define CI_FIN(r, it) titem_finish(r, it, scr, F.lane)
#if MK_CVD == 4
    CI_LOAD(r0, a0, 0); CI_LOAD(r1, a1, 1); CI_LOAD(r2, a2, 2); CI_LOAD(r3, a3, 3);
    CI_FIN(r0, a0); CI_LOAD(r0, a0, 4); CI_FIN(r1, a1); CI_LOAD(r1, a1, 5); CI_FIN(r2, a2); CI_LOAD(r2, a2, 6); CI_FIN(r3, a3); CI_LOAD(r3, a3, 7);
    CI_FIN(r0, a0); CI_FIN(r1, a1); CI_FIN(r2, a2); CI_FIN(r3, a3);
#elif MK_CVD == 5
    f32x4 r4[8]; TItem a4;
    CI_LOAD(r0, a0, 0); CI_LOAD(r1, a1, 1); CI_LOAD(r2, a2, 2); CI_LOAD(r3, a3, 3); CI_LOAD(r4, a4, 4);
    CI_FIN(r0, a0); CI_LOAD(r0, a0, 5); CI_FIN(r1, a1); CI_LOAD(r1, a1, 6); CI_FIN(r2, a2); CI_LOAD(r2, a2, 7);
    CI_FIN(r3, a3); CI_FIN(r4, a4); CI_FIN(r0, a0); CI_FIN(r1, a1); CI_FIN(r2, a2);
#else
    f32x4 r4[8], r5[8]; TItem a4, a5;
    CI_LOAD(r0, a0, 0); CI_LOAD(r1, a1, 1); CI_LOAD(r2, a2, 2); CI_LOAD(r3, a3, 3); CI_LOAD(r4, a4, 4); CI_LOAD(r5, a5, 5);
    CI_FIN(r0, a0); CI_LOAD(r0, a0, 6); CI_FIN(r1, a1); CI_LOAD(r1, a1, 7);
    CI_FIN(r2, a2); CI_FIN(r3, a3); CI_FIN(r4, a4); CI_FIN(r5, a5); CI_FIN(r0, a0); CI_FIN(r1, a1);
#endif
#undef CI_LOAD
#undef CI_FIN
}

template <class AP> __device__ __forceinline__ void convert_item1(const Ctx& F, AP ap, int item) {
    LAS float* scr = (LAS float*)(F.lds + RING_OFF + F.wave * 16384);
    f32x4 r0[8]; const TItem a0 = decode_item(F, ap, item); titem_load(r0, a0, F.lane); titem_finish(r0, a0, scr, F.lane);
}

template <class AP> __device__ __forceinline__ void phase0(const Ctx& F0, AP ap) {
    const Ctx F = fresh(F0);
#define in ap->in
    float* Mod = (float*)(F.ws + WS_MOD);
    if (F.bx < 192) {
        LAS float* sv = (LAS float*)F.lds; LAS float* part = sv + 5 * 1024;
        for (int i = F.tid; i < 5 * 1024; i += NWAVES * 64) { const int v = i >> 10, k = i & 1023; const float x = v < 4 ? in[1][v * 1024 + k] : in[3][k]; sv[i] = x / (1.f + __expf(-x)); }
        __syncthreads();
        const int l = F.bx / 96, n0 = (F.bx % 96) * 64, k0 = F.wave * 128;
        const float* w = in[4] + (size_t)l * 1024 * NMOD6 + n0 + F.lane;
        float a[5] = {0.f, 0.f, 0.f, 0.f, 0.f};
#pragma unroll 32
        for (int k = 0; k < 128; ++k) { const float wv = w[(size_t)(k0 + k) * NMOD6];
#pragma unroll
            for (int v = 0; v < 5; ++v) a[v] += sv[v * 1024 + k0 + k] * wv; }
#pragma unroll
        for (int v = 0; v < 5; ++v) part[(F.wave * 5 + v) * 64 + F.lane] = a[v];
        __syncthreads();
        if (F.tid < 320) { const int v = F.tid >> 6, ln = F.tid & 63; float s = 0.f;
#pragma unroll
            for (int ww = 0; ww < 8; ++ww) s += part[(ww * 5 + v) * 64 + ln];
            Mod[(size_t)(l * 5 + v) * NMOD6 + n0 + ln] = s + in[5][l * NMOD6 + n0 + ln]; }
        __syncthreads();
    }
    { const int idx = F.bx * (NWAVES * 64) + F.tid;
      if (idx < SEQ * 32) { const int t = idx >> 5, d = idx & 31; const float pos = d < 16 ? (float)(t >> 6) : (float)(t & 63);
          const float inv = exp2f(-(float)(2 * (d & 15)) * (13.287712379549449f / 32.f)); const float ang = pos * inv;
          ((float*)(F.ws + WS_ROPE))[idx] = cosf(ang); ((float*)(F.ws + WS_ROPE))[SEQ * 32 + idx] = sinf(ang); } }
#undef in
    convert_items(F, ap, F.vcu * NWAVES + F.wave, I_SMALL, F.G * NWAVES);
}

struct Row16 { f32x4 a[2][2]; };
__device__ __forceinline__ void ld_f32(Row16& r, const float* row, int lane) {
#pragma unroll
    for (int jj = 0; jj < 2; ++jj) { r.a[jj][0] = ((const f32x4*)row)[2 * (lane + 64 * jj)]; r.a[jj][1] = ((const f32x4*)row)[2 * (lane + 64 * jj) + 1]; } }
__device__ __forceinline__ void un_bf16(Row16& r, const v4u (&w)[2]) {
#pragma unroll
    for (int jj = 0; jj < 2; ++jj) { r.a[jj][0] = (f32x4){bf_lo(w[jj][0]), bf_hi(w[jj][0]), bf_lo(w[jj][1]), bf_hi(w[jj][1])}; r.a[jj][1] = (f32x4){bf_lo(w[jj][2]), bf_hi(w[jj][2]), bf_lo(w[jj][3]), bf_hi(w[jj][3])}; } }
__device__ __forceinline__ void st_bf16(bf16* row, int lane, const Row16& r) {
#pragma unroll
    for (int jj = 0; jj < 2; ++jj) ((v4u*)row)[lane + 64 * jj] = pg8::pack8(r.a[jj][0], r.a[jj][1]); }
__device__ __forceinline__ float sumsq(const Row16& r) { return (dot4(r.a[0][0], r.a[0][0]) + dot4(r.a[0][1], r.a[0][1])) + (dot4(r.a[1][0], r.a[1][0]) + dot4(r.a[1][1], r.a[1][1])); }

__device__ __forceinline__ void phase_norm1(const Ctx& F0, const float* src, const float* ctxsrc, const float* g1, const float* modl) {
    const Ctx F = fresh(F0);
    bf16* XN = (bf16*)(F.ws + WS_XN);
    const int gw = F.vcu * NWAVES + F.wave, NGW = F.G * NWAVES;
    for (int grp = gw; grp < 2048 + 128; grp += NGW) {
        const bool isc = grp >= 2048; const int row0 = isc ? (grp - 2048) * 8 : grp * 8;
        const float* sp = (isc ? ctxsrc : src) + (size_t)row0 * DM; bf16* dp = XN + (size_t)(isc ? MTOK + row0 : row0) * DM;
        const float* mm = modl + (size_t)(isc ? 4 : (row0 >> 12)) * NMOD6;
        Row16 v[8];
#pragma unroll
        for (int r = 0; r < 8; ++r) ld_f32(v[r], sp + (size_t)r * DM, F.lane);
        Row16 gs, sh, tmp; ld_f32(gs, g1, F.lane); ld_f32(tmp, mm + 1024, F.lane); ld_f32(sh, mm, F.lane);
        asm volatile("" ::: "memory");
#pragma unroll
        for (int jj = 0; jj < 2; ++jj)
#pragma unroll
            for (int hf = 0; hf < 2; ++hf) gs.a[jj][hf] = gs.a[jj][hf] * (tmp.a[jj][hf] + 1.0f);
        float ss[8];
#pragma unroll
        for (int r = 0; r < 8; ++r) ss[r] = sumsq(v[r]);
#pragma unroll
        for (int r = 0; r < 8; ++r) ss[r] = wave_sum(ss[r], F.lane);
#pragma unroll
        for (int r = 0; r < 8; ++r) { const float rstd = __builtin_amdgcn_rsqf(ss[r] * (1.f / DM) + EPSN); Row16 o;
#pragma unroll
            for (int jj = 0; jj < 2; ++jj)
#pragma unroll
                for (int hf = 0; hf < 2; ++hf) o.a[jj][hf] = v[r].a[jj][hf] * rstd * gs.a[jj][hf] + sh.a[jj][hf];
            st_bf16(dp + (size_t)r * DM, F.lane, o); }
    }
}

__device__ __forceinline__ float row16_max(float v) {
#define R16(ctrl) __builtin_bit_cast(float, __builtin_amdgcn_update_dpp(__builtin_bit_cast(int, v), __builtin_bit_cast(int, v), (ctrl), 0xF, 0xF, false))
    v = fmaxf(v, R16(0xB1)); v = fmaxf(v, R16(0x4E)); v = fmaxf(v, R16(0x141)); v = fmaxf(v, R16(0x140)); return v;
#undef R16
}
__device__ __forceinline__ float row16_sum(float v) {
#define R16(ctrl) __builtin_bit_cast(float, __builtin_amdgcn_update_dpp(0, __builtin_bit_cast(int, v), (ctrl), 0xF, 0xF, false))
    v += R16(0xB1); v += R16(0x4E); v += R16(0x141); v += R16(0x140); return v;
#undef R16
}
__device__ __forceinline__ void phase_norm2_router(const Ctx& F0, const float* g2, const float* modl, const float* wr) {
    const Ctx F = fresh(F0);
    const bf16* Hb = (const bf16*)(F.ws + WS_H); bf16* XN = (bf16*)(F.ws + WS_XN); float* AFF = (float*)(F.ws + WS_AFF);
    LAS v4u* BH = (LAS v4u*)F.lds; LAS v4u* BL = BH + 2048; LAS float* pbl = (LAS float*)(F.lds + 65536); LAS float* biasl = pbl + 512;
    for (int blk = F.vcu; blk < MTOK / 64; blk += F.G) {
        const int rowb = blk * 64, row0 = rowb + F.wave * 8; const float* mm = modl + (size_t)(rowb >> 12) * NMOD6;
        v4u cur[2][2], nxt[2][2];
#pragma unroll
        for (int rr = 0; rr < 2; ++rr)
#pragma unroll
            for (int jj = 0; jj < 2; ++jj) cur[rr][jj] = ((const v4u*)(Hb + (size_t)(row0 + rr) * DM))[F.lane + 64 * jj];
        __syncthreads();
        { const int e = F.tid & 15, kq = (F.tid & 63) >> 4; float pb = 0.f;
#pragma unroll
          for (int q = 0; q < 4; ++q) { const int fid = F.tid + 512 * q, s = fid >> 6, c0 = 32 * s + 8 * kq; float wv[8], lo[8]; unsigned hb[8];
#pragma unroll
              for (int j = 0; j < 8; ++j) { const int c = c0 + j; const float w = wr[(size_t)c * NE + e]; wv[j] = g2[c] * (mm[4 * 1024 + c] + 1.0f) * w; pb += mm[3 * 1024 + c] * w;
                  hb[j] = f2bf(wv[j]); lo[j] = wv[j] - __builtin_bit_cast(float, hb[j] << 16); }
              BH[fid] = (v4u){hb[0] | (hb[1] << 16), hb[2] | (hb[3] << 16), hb[4] | (hb[5] << 16), hb[6] | (hb[7] << 16)};
              BL[fid] = (v4u){pk2(lo[0], lo[1]), pk2(lo[2], lo[3]), pk2(lo[4], lo[5]), pk2(lo[6], lo[7])}; }
          pbl[F.tid] = pb; }
        Row16 gs, sh;
        { Row16 tmp; ld_f32(gs, g2, F.lane); ld_f32(tmp, mm + 4 * 1024, F.lane); ld_f32(sh, mm + 3 * 1024, F.lane);
#pragma unroll
          for (int jj = 0; jj < 2; ++jj)
#pragma unroll
            for (int hf = 0; hf < 2; ++hf) gs.a[jj][hf] = gs.a[jj][hf] * (tmp.a[jj][hf] + 1.0f); }
        __syncthreads();
        if (F.tid < 16) { float s = 0.f;
#pragma unroll
            for (int w = 0; w < 8; ++w)
#pragma unroll
                for (int k4 = 0; k4 < 4; ++k4) s += pbl[w * 64 + k4 * 16 + F.tid];
            biasl[F.tid] = s; }
        float rstd[8];
#pragma unroll
        for (int rp = 0; rp < 4; ++rp) {
            if (rp < 3) {
#pragma unroll
                for (int rr = 0; rr < 2; ++rr)
#pragma unroll
                    for (int jj = 0; jj < 2; ++jj) nxt[rr][jj] = ((const v4u*)(Hb + (size_t)(row0 + 2 * rp + 2 + rr) * DM))[F.lane + 64 * jj]; }
#pragma unroll
            for (int rr = 0; rr < 2; ++rr) { Row16 x; un_bf16(x, cur[rr]);
                rstd[2 * rp + rr] = __builtin_amdgcn_rsqf(wave_sum(sumsq(x), F.lane) * (1.f / DM) + EPSN);
                Row16 o;
#pragma unroll
                for (int jj = 0; jj < 2; ++jj)
#pragma unroll
                    for (int hf = 0; hf < 2; ++hf) o.a[jj][hf] = x.a[jj][hf] * rstd[2 * rp + rr] * gs.a[jj][hf] + sh.a[jj][hf];
                st_bf16(XN + (size_t)(row0 + 2 * rp + rr) * DM, F.lane, o); }
#pragma unroll
            for (int rr = 0; rr < 2; ++rr)
#pragma unroll
                for (int jj = 0; jj < 2; ++jj) cur[rr][jj] = nxt[rr][jj];
        }
        __syncthreads();
        { const int r = F.lane & 7, kq = F.lane >> 4; const bf16* ap = Hb + (size_t)(row0 + r) * DM + 8 * kq;
          pg8::f32x4 acc = (pg8::f32x4){0.f, 0.f, 0.f, 0.f};
#pragma unroll
          for (int sg = 0; sg < 4; ++sg) { pg8::bf16x8 af[8];
#pragma unroll
              for (int k = 0; k < 8; ++k) af[k] = *(const pg8::bf16x8*)(ap + 32 * (8 * sg + k));
#pragma unroll
              for (int k = 0; k < 8; ++k) { const int s = 8 * sg + k; const pg8::bf16x8 bh = __builtin_bit_cast(pg8::bf16x8, BH[s * 64 + F.lane]), bl = __builtin_bit_cast(pg8::bf16x8, BL[s * 64 + F.lane]);
                  acc = __builtin_amdgcn_mfma_f32_16x16x32_bf16(af[k], bh, acc, 0, 0, 0); acc = __builtin_amdgcn_mfma_f32_16x16x32_bf16(af[k], bl, acc, 0, 0, 0); } }
          const float be = biasl[F.lane & 15]; const bool lowq = kq == 0;
#pragma unroll
          for (int reg = 0; reg < 4; ++reg) { const float rs = lowq ? rstd[reg] : rstd[4 + reg]; const float lg = acc[reg] * rs + be;
              const float mx = row16_max(lg), p = __expf(lg - mx), s = row16_sum(p);
              if (kq < 2) AFF[(size_t)(row0 + 4 * kq + reg) * NE + (F.lane & 15)] = p / s; } }
        __syncthreads();
    }
}

__device__ __forceinline__ int block_excl_scan(const Ctx& F, int x, LAS int* scr, int& total) {
    int inc = x;
#pragma unroll
    for (int o = 1; o < 64; o <<= 1) { const int y = __builtin_amdgcn_ds_bpermute(((F.lane - o) & 63) << 2, inc); if (F.lane >= o) inc += y; }
    __syncthreads();
    if (F.lane == 63) scr[F.wave] = inc;
    __syncthreads();
    int base = 0, tot = 0;
#pragma unroll
    for (int w = 0; w < 8; ++w) { const int c = scr[w]; if (w < F.wave) base += c; tot += c; }
    total = tot; return base + inc - x;
}
__device__ __forceinline__ void phase_topk(const Ctx& F0) {
    const Ctx F = fresh(F0);
    if (F.bx >= NB * NE) return;
    const float* AFF = (const float*)(F.ws + WS_AFF); float* GV = (float*)(F.ws + WS_GV); unsigned* GOFF = (unsigned*)(F.ws + WS_GOFF); int* INV = (int*)(F.ws + WS_INV);
    const int b = F.bx >> 4, e = F.bx & 15;
    LAS int* cnt = (LAS int*)F.lds;
    unsigned v[8];
#pragma unroll
    for (int k = 0; k < 8; ++k) v[k] = __builtin_bit_cast(unsigned, AFF[((size_t)b * SEQ + F.tid * 8 + k) * NE + e]);
    LAS unsigned* hist = (LAS unsigned*)F.lds + 64;
    LAS unsigned* pick = hist + 256;
    unsigned T = 0u; int krem = CAP;
#pragma unroll 1
    for (int pass = 0; pass < 4; ++pass) {
        const int shift = 24 - 8 * pass;
        if (F.tid < 256) hist[F.tid] = 0u;
        __syncthreads();
#pragma unroll
        for (int k = 0; k < 8; ++k) if (pass == 0 || (v[k] >> (shift + 8)) == T) __hip_atomic_fetch_add(hist + ((v[k] >> shift) & 255u), 1u, __ATOMIC_RELAXED, __HIP_MEMORY_SCOPE_WORKGROUP);
        __syncthreads();
        if (F.wave == 0) {
            const int c0 = (int)hist[4 * F.lane], c1 = (int)hist[4 * F.lane + 1], c2 = (int)hist[4 * F.lane + 2], c3 = (int)hist[4 * F.lane + 3];
            const int s = c0 + c1 + c2 + c3; int t = s;
#pragma unroll
            for (int o = 1; o < 64; o <<= 1) { const int y = __builtin_amdgcn_ds_bpermute(((F.lane + o) & 63) << 2, t); if (F.lane + o < 64) t += y; }
            const int excl = t - s;
            if (excl < krem && krem <= t) { int r = krem - excl, d;
                if (r <= c3) d = 3; else { r -= c3; if (r <= c2) d = 2; else { r -= c2; if (r <= c1) d = 1; else { r -= c1; d = 0; } } }
                pick[0] = (unsigned)(4 * F.lane + d); pick[1] = (unsigned)r; }
        }
        __syncthreads();
        T = (T << 8) | pick[0]; krem = (int)pick[1];
    }
    int tc = 0, gc = 0;
#pragma unroll
    for (int k = 0; k < 8; ++k) { tc += (v[k] == T) ? 1 : 0; gc += (v[k] > T) ? 1 : 0; }
    int ttot, stot;
    const int tp = block_excl_scan(F, tc, cnt + 32, ttot);
    const int need = krem;
    int tsel = need - tp; tsel = tsel < 0 ? 0 : (tsel > tc ? tc : tsel);
    int slot = block_excl_scan(F, gc + tsel, cnt + 32, stot);
    int tpr = tp;
#pragma unroll
    for (int k = 0; k < 8; ++k) { const int t = F.tid * 8 + k; const bool tie = v[k] == T; const bool sel = v[k] > T || (tie && tpr < need); if (tie) ++tpr;
        const size_t tokrow = (size_t)b * SEQ + t;
        if (sel) { const size_t R = (size_t)(e * NB + b) * CAP + slot; GOFF[R] = (unsigned)(tokrow * (DM * 2)); GV[R] = __builtin_bit_cast(float, v[k]); INV[tokrow * NE + e] = slot; ++slot; }
        else INV[tokrow * NE + e] = -1; }
}

template <bool FINAL>
__device__ __forceinline__ void phase_combine(const Ctx& F0, const float* modl, const float* gnext, const float* modnext, float* out) {
    const Ctx F = fresh(F0);
    bf16* Hb = (bf16*)(F.ws + WS_H); bf16* XN = (bf16*)(F.ws + WS_XN); const bf16* Y = (const bf16*)(F.ws + WS_RA + RA_Y);
    const float* GV = (const float*)(F.ws + WS_GV); const int* INV = (const int*)(F.ws + WS_INV);
    const int gw = F.vcu * NWAVES + F.wave, NGW = F.G * NWAVES;
    for (int grp = gw; grp < 2048; grp += NGW) {
        const int row0 = grp * 8, b = row0 >> 12; const float* mm = modl + (size_t)b * NMOD6;
        int sl0, sl1; float gv0, gv1;
        { const int e = F.lane & 15, rr = F.lane >> 4;
          sl0 = INV[(size_t)(row0 + rr) * NE + e]; sl1 = INV[(size_t)(row0 + 4 + rr) * NE + e];
          gv0 = sl0 >= 0 ? GV[(size_t)(e * NB + b) * CAP + sl0] : 0.f; gv1 = sl1 >= 0 ? GV[(size_t)(e * NB + b) * CAP + sl1] : 0.f; }
        const unsigned long long mk0 = __ballot(sl0 >= 0), mk1 = __ballot(sl1 >= 0);
        const int gi0 = __builtin_bit_cast(int, gv0), gi1 = __builtin_bit_cast(int, gv1);
        Row16 g2, gs, sh; ld_f32(g2, mm + 5 * 1024, F.lane); ld_f32(gs, gnext, F.lane);
        if (!FINAL) { const float* mn = modnext + (size_t)b * NMOD6; Row16 tmp; ld_f32(tmp, mn + 1024, F.lane); ld_f32(sh, mn, F.lane);
#pragma unroll
            for (int jj = 0; jj < 2; ++jj)
#pragma unroll
                for (int hf = 0; hf < 2; ++hf) gs.a[jj][hf] = gs.a[jj][hf] * (tmp.a[jj][hf] + 1.0f); }
#pragma unroll
        for (int hh = 0; hh < 2; ++hh) {
        v4u ya[8][2], yb[8][2], hw[8][2]; float ga[8], gb[8]; unsigned rest[8];
#pragma unroll
        for (int r = 4 * hh; r < 4 * hh + 4; ++r)
#pragma unroll
            for (int jj = 0; jj < 2; ++jj) hw[r][jj] = ((const v4u*)(Hb + (size_t)(row0 + r) * DM))[F.lane + 64 * jj];
#pragma unroll
        for (int r = 4 * hh; r < 4 * hh + 4; ++r) { const int slv = r < 4 ? sl0 : sl1, giv = r < 4 ? gi0 : gi1, lb = (r & 3) * 16;
            unsigned mask = (unsigned)(((r < 4 ? mk0 : mk1) >> lb) & 0xFFFFull);
            const bool one = mask != 0u; const int ea = one ? __builtin_ctz(mask) : 0; if (one) mask &= mask - 1; const bool two = mask != 0u; const int eb = two ? __builtin_ctz(mask) : ea; if (two) mask &= mask - 1;
            rest[r] = mask;
            const int sa = __builtin_amdgcn_readlane(slv, lb + ea), sb = __builtin_amdgcn_readlane(slv, lb + eb);
            ga[r] = one ? __builtin_bit_cast(float, __builtin_amdgcn_readlane(giv, lb + ea)) : 0.f; gb[r] = two ? __builtin_bit_cast(float, __builtin_amdgcn_readlane(giv, lb + eb)) : 0.f;
            const bf16* pa = Y + ((size_t)(ea * NB + b) * CAP + (one ? sa : 0)) * DM; const bf16* pb = Y + ((size_t)(eb * NB + b) * CAP + (one ? sb : 0)) * DM;
#pragma unroll
            for (int jj = 0; jj < 2; ++jj) { ya[r][jj] = ((const v4u*)pa)[F.lane + 64 * jj]; yb[r][jj] = ((const v4u*)pb)[F.lane + 64 * jj]; } }
        asm volatile("" ::: "memory");
#if MK_COMB4
        Row16 h4[4];
#pragma unroll
        for (int k = 0; k < 4; ++k) { const int r = 4 * hh + k; Row16 acc, t; un_bf16(h4[k], hw[r]); un_bf16(acc, ya[r]); un_bf16(t, yb[r]);
#pragma unroll
            for (int jj = 0; jj < 2; ++jj)
#pragma unroll
                for (int hf = 0; hf < 2; ++hf) h4[k].a[jj][hf] += g2.a[jj][hf] * (acc.a[jj][hf] * ga[r] + t.a[jj][hf] * gb[r]); }
        if ((rest[4 * hh] | rest[4 * hh + 1] | rest[4 * hh + 2] | rest[4 * hh + 3]) != 0u) {
            v4u yc[4][2], yd[4][2]; float gc4[4], gd4[4]; bool has3[4], has4[4];
#pragma unroll
            for (int k = 0; k < 4; ++k) { const int r = 4 * hh + k; const int slv = r < 4 ? sl0 : sl1, giv = r < 4 ? gi0 : gi1, lb = (r & 3) * 16; unsigned mask = rest[r];
                const bool three = mask != 0u; const int ec = three ? __builtin_ctz(mask) : 0; if (three) mask &= mask - 1; const bool four = mask != 0u; const int ed = four ? __builtin_ctz(mask) : ec; if (four) mask &= mask - 1;
                rest[r] = mask; has3[k] = three; has4[k] = four; gc4[k] = 0.f; gd4[k] = 0.f;
#pragma unroll
                for (int jj = 0; jj < 2; ++jj) { yc[k][jj] = (v4u){0u, 0u, 0u, 0u}; yd[k][jj] = (v4u){0u, 0u, 0u, 0u}; }
                if (three) { const int sc = __builtin_amdgcn_readlane(slv, lb + ec); gc4[k] = __builtin_bit_cast(float, __builtin_amdgcn_readlane(giv, lb + ec));
                    const bf16* pc = Y + ((size_t)(ec * NB + b) * CAP + sc) * DM;
#pragma unroll
                    for (int jj = 0; jj < 2; ++jj) yc[k][jj] = ((const v4u*)pc)[F.lane + 64 * jj]; }
                if (four) { const int sd = __builtin_amdgcn_readlane(slv, lb + ed); gd4[k] = __builtin_bit_cast(float, __builtin_amdgcn_readlane(giv, lb + ed));
                    const bf16* pd = Y + ((size_t)(ed * NB + b) * CAP + sd) * DM;
#pragma unroll
                    for (int jj = 0; jj < 2; ++jj) yd[k][jj] = ((const v4u*)pd)[F.lane + 64 * jj]; } }
            asm volatile("" ::: "memory");
#pragma unroll
            for (int k = 0; k < 4; ++k) { const int r = 4 * hh + k; Row16 acc, t; un_bf16(acc, yc[k]); un_bf16(t, yd[k]);
#pragma unroll
                for (int jj = 0; jj < 2; ++jj)
#pragma unroll
                    for (int hf = 0; hf < 2; ++hf) h4[k].a[jj][hf] += g2.a[jj][hf] * (acc.a[jj][hf] * gc4[k] + t.a[jj][hf] * gd4[k]);
                unsigned mask = rest[r];
                if (mask) { const int slv = r < 4 ? sl0 : sl1, giv = r < 4 ? gi0 : gi1, lb = (r & 3) * 16;
                    while (mask) {
                        const int ec = __builtin_ctz(mask); mask &= mask - 1;
                        const int sc = __builtin_amdgcn_readlane(slv, lb + ec); const float gc = __builtin_bit_cast(float, __builtin_amdgcn_readlane(giv, lb + ec));
                        const bf16* pc = Y + ((size_t)(ec * NB + b) * CAP + sc) * DM; v4u ye[2];
#pragma unroll
                        for (int jj = 0; jj < 2; ++jj) ye[jj] = ((const v4u*)pc)[F.lane + 64 * jj];
                        un_bf16(t, ye);
#pragma unroll
                        for (int jj = 0; jj < 2; ++jj)
#pragma unroll
                            for (int hf = 0; hf < 2; ++hf) h4[k].a[jj][hf] += g2.a[jj][hf] * (t.a[jj][hf] * gc); } } }
        }
#pragma unroll
        for (int k = 0; k < 4; ++k) { const int row = row0 + 4 * hh + k; Row16& h = h4[k];
            const float rstd = __builtin_amdgcn_rsqf(wave_sum(sumsq(h), F.lane) * (1.f / DM) + EPSN);
            if (FINAL) {
#pragma unroll
                for (int jj = 0; jj < 2; ++jj)
#pragma unroll
                    for (int hf = 0; hf < 2; ++hf) ((f32x4*)(out + (size_t)row * DM))[2 * (F.lane + 64 * jj) + hf] = h.a[jj][hf] * rstd * gs.a[jj][hf];
            } else { st_bf16(Hb + (size_t)row * DM, F.lane, h); Row16 o;
#pragma unroll
                for (int jj = 0; jj < 2; ++jj)
#pragma unroll
                    for (int hf = 0; hf < 2; ++hf) o.a[jj][hf] = h.a[jj][hf] * rstd * gs.a[jj][hf] + sh.a[jj][hf];
                st_bf16(XN + (size_t)row * DM, F.lane, o); }
        }
#else
#pragma unroll
        for (int r = 4 * hh; r < 4 * hh + 4; ++r) { const int row = row0 + r; Row16 h, acc, t; un_bf16(h, hw[r]);
            un_bf16(acc, ya[r]); un_bf16(t, yb[r]);
#pragma unroll
            for (int jj = 0; jj < 2; ++jj)
#pragma unroll
                for (int hf = 0; hf < 2; ++hf) acc.a[jj][hf] = acc.a[jj][hf] * ga[r] + t.a[jj][hf] * gb[r];
            unsigned mask = rest[r];
            if (mask) { const int slv = r < 4 ? sl0 : sl1, giv = r < 4 ? gi0 : gi1, lb = (r & 3) * 16;
                while (mask) {
                    const int ec = __builtin_ctz(mask); mask &= mask - 1;
                    const int sc = __builtin_amdgcn_readlane(slv, lb + ec); const float gc = __builtin_bit_cast(float, __builtin_amdgcn_readlane(giv, lb + ec));
                    const bf16* pc = Y + ((size_t)(ec * NB + b) * CAP + sc) * DM; v4u yc[2];
#pragma unroll
                    for (int jj = 0; jj < 2; ++jj) yc[jj] = ((const v4u*)pc)[F.lane + 64 * jj];
                    un_bf16(t, yc);
#pragma unroll
                    for (int jj = 0; jj < 2; ++jj)
#pragma unroll
                        for (int hf = 0; hf < 2; ++hf) acc.a[jj][hf] += t.a[jj][hf] * gc; } }
#pragma unroll
            for (int jj = 0; jj < 2; ++jj)
#pragma unroll
                for (int hf = 0; hf < 2; ++hf) h.a[jj][hf] += g2.a[jj][hf] * acc.a[jj][hf];
            const float rstd = __builtin_amdgcn_rsqf(wave_sum(sumsq(h), F.lane) * (1.f / DM) + EPSN);
            if (FINAL) {
#pragma unroll
                for (int jj = 0; jj < 2; ++jj)
#pragma unroll
                    for (int hf = 0; hf < 2; ++hf) ((f32x4*)(out + (size_t)row * DM))[2 * (F.lane + 64 * jj) + hf] = h.a[jj][hf] * rstd * gs.a[jj][hf];
            } else { st_bf16(Hb + (size_t)row * DM, F.lane, h); Row16 o;
#pragma unroll
                for (int jj = 0; jj < 2; ++jj)
#pragma unroll
                    for (int hf = 0; hf < 2; ++hf) o.a[jj][hf] = h.a[jj][hf] * rstd * gs.a[jj][hf] + sh.a[jj][hf];
                st_bf16(XN + (size_t)row * DM, F.lane, o); }
        }
#endif
        }
    }
}

__device__ __forceinline__ void phase_sconv(const Ctx& F0, const float* w) {
    const Ctx F = fresh(F0);
    const bf16* BG = (const bf16*)(F.ws + WS_RA + RA_BG); const bf16* CX = (const bf16*)(F.ws + WS_RA + RA_CX); bf16* Z = (bf16*)(F.ws + WS_HID);
    const int gw = F.vcu * NWAVES + F.wave, NGW = F.G * NWAVES;
    const v4u zero4 = (v4u){0u, 0u, 0u, 0u};
    for (int grp = gw; grp < 2048; grp += NGW) {
        const int row0 = grp * 8, t0 = row0 & (SEQ - 1);
        v4u cx[10][2], bg[8][2];
#pragma unroll
        for (int r = 0; r < 10; ++r) { const bool ok = (t0 + r - 1) >= 0 && (t0 + r - 1) < SEQ;
#pragma unroll
            for (int jj = 0; jj < 2; ++jj) cx[r][jj] = ok ? ((const v4u*)(CX + (size_t)(row0 + r - 1) * DM))[F.lane + 64 * jj] : zero4; }
#pragma unroll
        for (int r = 0; r < 8; ++r)
#pragma unroll
            for (int jj = 0; jj < 2; ++jj) bg[r][jj] = ((const v4u*)(BG + (size_t)(row0 + r) * DM))[F.lane + 64 * jj];
        Row16 wk[3];
#pragma unroll
        for (int k = 0; k < 3; ++k) ld_f32(wk[k], w + k * DM, F.lane);
        asm volatile("" ::: "memory");
#pragma unroll
        for (int r = 0; r < 8; ++r) { Row16 p, c, n, g, o; un_bf16(p, cx[r]); un_bf16(c, cx[r + 1]); un_bf16(n, cx[r + 2]); un_bf16(g, bg[r]);
#pragma unroll
            for (int jj = 0; jj < 2; ++jj)
#pragma unroll
                for (int hf = 0; hf < 2; ++hf) o.a[jj][hf] = g.a[jj][hf] * (wk[0].a[jj][hf] * p.a[jj][hf] + wk[1].a[jj][hf] * c.a[jj][hf] + wk[2].a[jj][hf] * n.a[jj][hf]);
            st_bf16(Z + (size_t)(row0 + r) * DM, F.lane, o); }
    }
}

__device__ __forceinline__ void conv_unit(const Ctx& F0, int unit, const float* cw, const float* cb, const float* lg, const float* lb) {
    const Ctx F = fresh(F0);
    const bf16* G = (const bf16*)(F.ws + WS_RA + RA_G); bf16* ZO = (bf16*)(F.ws + WS_RA + RA_ZO);
    LAS unsigned char* IN = F.lds; LAS float* OUT = (LAS float*)(F.lds + 63488);
    const int row0 = unit * 32, b = row0 >> 12, t0 = row0 & (SEQ - 1);
#pragma unroll
    for (int k = 0; k < 8; ++k) { const int ch = F.tid + 512 * k; if (ch < 62 * 64) { const int r = ch >> 6, c16 = ch & 63, tt = t0 - 15 + r;
        v4u val = (v4u){0u, 0u, 0u, 0u}; if (tt >= 0 && tt < SEQ) val = *(const v4u*)(G + ((size_t)b * SEQ + tt) * 512 + c16 * 8);
        *(LAS v4u*)(IN + r * 1024 + c16 * 16) = val; } }
    __syncthreads();
    { const int cp = F.tid & 255, rh = F.tid >> 8;
      typedef float f32x2 __attribute__((ext_vector_type(2)));
      f32x2 wv[31];
#pragma unroll
      for (int k = 0; k < 31; ++k) wv[k] = *(const f32x2*)(cw + k * 512 + 2 * cp);
      const f32x2 bias = *(const f32x2*)(cb + 2 * cp);
      f32x2 a[16];
#pragma unroll
      for (int r = 0; r < 16; ++r) a[r] = bias;
#pragma unroll
      for (int j = 0; j < 46; ++j) { const unsigned wd = *(const LAS unsigned*)(IN + (16 * rh + j) * 1024 + cp * 4); const f32x2 x = (f32x2){bf_lo(wd), bf_hi(wd)};
#pragma unroll
          for (int r = 0; r < 16; ++r) { if (j - r >= 0 && j - r < 31) a[r] += x * wv[j - r]; } }
#pragma unroll
      for (int r = 0; r < 16; ++r) *(LAS f32x2*)(OUT + (16 * rh + r) * 512 + 2 * cp) = a[r]; }
    __syncthreads();
    { f32x4 lgv[2], lbv[2];
#pragma unroll
      for (int j = 0; j < 2; ++j) { lgv[j] = ((const f32x4*)lg)[F.lane + 64 * j]; lbv[j] = ((const f32x4*)lb)[F.lane + 64 * j]; }
#pragma unroll
      for (int rr = 0; rr < 4; ++rr) { const int r = F.wave * 4 + rr; f32x4 x[2];
#pragma unroll
          for (int j = 0; j < 2; ++j) x[j] = ((const LAS f32x4*)(OUT + r * 512))[F.lane + 64 * j];
          const float mu = wave_sum(sum4(x[0]) + sum4(x[1]), F.lane) * (1.f / 512.f);
          x[0] = x[0] - mu; x[1] = x[1] - mu;
          const float rstd = __builtin_amdgcn_rsqf(wave_sum(dot4(x[0], x[0]) + dot4(x[1], x[1]), F.lane) * (1.f / 512.f) + EPSN);
#pragma unroll
          for (int j = 0; j < 2; ++j) { f32x4 y = x[j] * rstd * lgv[j] + lbv[j];
#pragma unroll
              for (int i = 0; i < 4; ++i) y[i] = y[i] * pg8::fast_sigmoid(y[i]);
              ((u32x2*)(ZO + (size_t)(row0 + r) * DM + 512))[F.lane + 64 * j] = pack4(y); } } }
    __syncthreads();
}

struct Args { const float* in[24]; float* out; unsigned char* ws; int ph_lo, ph_hi; };
typedef const Args __attribute__((address_space(4))) CArgs;
#define FRESH_ARGS() ({ CArgs* a_ = (CArgs*)__builtin_amdgcn_kernarg_segment_ptr(); asm volatile("" : "+s"(a_)); a_; })
__device__ __forceinline__ Ctx make_ctx(unsigned char* lds_raw) {
    Ctx F; F.lds = (LAS unsigned char*)lds_raw;
    { CArgs* a = FRESH_ARGS(); F.ws = a->ws; }
    int t = threadIdx.x; asm volatile("" : "+v"(t));
    F.tid = t; F.lane = t & 63; F.wave = __builtin_amdgcn_readfirstlane(t >> 6);
    F.G = gridDim.x; F.bx = blockIdx.x; F.vcu = (F.G % 8 == 0) ? (F.bx % 8) * (F.G / 8) + F.bx / 8 : F.bx;
    return F;
}
__global__ void __launch_bounds__(NWAVES * 64, 2) mk_fwd(Args args_unused) {
    extern __shared__ __attribute__((aligned(16))) unsigned char lds_raw[];
    { const int t = threadIdx.x; for (int u = t; u < (LDS_BYTES - LDSCTL_OFF) / 4; u += NWAVES * 64) ((LAS unsigned*)((LAS unsigned char*)lds_raw + LDSCTL_OFF))[u] = 0u; }
    __syncthreads();
#if !MK_PER_PHASE
    { CArgs* a = FRESH_ARGS(); (void)xcd_barrier_post((unsigned*)(a->ws + WS_CTL) + CW_BAR, (volatile LAS unsigned*)((LAS unsigned char*)lds_raw + MISC_OFF) + 8); }
#endif
    int lo, hi; { CArgs* a = FRESH_ARGS(); lo = a->ph_lo; hi = a->ph_hi; }
#ifdef MK_SPINTEST
    if (threadIdx.x == 0 && blockIdx.x == 0) { const unsigned long long t0 = rt(); while (rt() - t0 < (unsigned long long)(MK_SPINTEST)) __builtin_amdgcn_s_sleep(8); }
    __syncthreads();
#endif
#if MK_TPROBE
    if (threadIdx.x == 0 && blockIdx.x == 0) { CArgs* a = FRESH_ARGS(); unsigned long long* TSW = (unsigned long long*)(a->ws + WS_CTL + 131072); const unsigned long long now = rt();
#if MK_TPROBE == 2
        unsigned long long mx = 0ull; for (int i = 0; i < 256; ++i) { const unsigned long long v = __hip_atomic_load(TSW + 17 * 256 + i, RLX_AGENT); mx = v > mx ? v : mx; }
        TSW[18 * 256 + 32] = now - mx;
#endif
        TSW[18 * 256 + 0] = now; }
#endif
#if !MK_PER_PHASE && MK_COOP_MARK
    if (hi > NPHASE) cooperative_groups::this_grid().sync();
#endif
#ifndef MK_PHMASK
#define MK_PHMASK 0x3ffff
#endif
#define PH(k) case k: if (!(((MK_PHMASK) >> (k)) & 1)) break;
#define WSP(T, off) ((T*)(F.ws + (off)))
#ifndef MK_PASSES
#define MK_PASSES 1
#endif
#if MK_PASSES > 1
    for (int it_ = 0; it_ < MK_PASSES * NPHASE; ++it_) { const int pass = it_ / NPHASE, ph = it_ % NPHASE;
#else
    for (int ph = lo; ph < hi; ++ph) { const int pass = 0;
#endif
        const int l = ph >= 13 ? 1 : 0;
        __builtin_amdgcn_s_waitcnt(0);
        const Ctx F = make_ctx(lds_raw); LAS unsigned char* ring = F.lds + RING_OFF;
        switch (ph) {
        PH(0) { CArgs* a = FRESH_ARGS(); phase0(F, a); } break;
        PH(1) { CArgs* a = FRESH_ARGS(); phase_norm1(F, a->in[0], a->in[2], a->in[6], WSP(float, WS_MOD)); } break;
        PH(12) {
            pg8::Gemm g{WSP(bf16, WS_HID)  , WSP(bf16, WS_SCOUT), MTOK, DM, DM, 1 << 30, 0};
            pg8::StaticOrder S; S.init(MTOK, DM, F.G, F.bx);
            pg8::EpiResB<true> E{WSP(bf16, WS_H), WSP(bf16, WS_H), WSP(float, WS_MOD) + (size_t)5 * NMOD6 + 2 * 1024, NMOD6};
            pg8::gemm_phase<pg8::EpiResB<true>, pg8::StaticOrder, false, false>(ring, g, S, E);
        } break;
        PH(2) {
            CArgs* a = FRESH_ARGS();
            pg8::Gemm g{WSP(bf16, WS_XN), WSP(bf16, WS_WIN), MTOK, EIN, DM, 1 << 30, 0};
            pg8::OrderL0 S; S.init(F.G, F.bx);
            pg8::EpiL0 E{WSP(bf16, WS_RA + RA_Q), WSP(bf16, WS_KB), WSP(bf16, WS_VB), WSP(bf16, WS_RA + RA_G), WSP(float, WS_ROPE), WSP(float, WS_ROPE) + SEQ * 32, a->in[9], a->in[10], attn_body::C2};
            pg8::gemm_phase<pg8::EpiL0, pg8::OrderL0, true, false>(ring, g, S, E);
        } break;
        PH(3) {
            CArgs* a = FRESH_ARGS(); const int nchunk = (lo == 0 && hi == NPHASE) ? NCHUNK : I_MOE / CHUNK_ITEMS;
            gu32* pool = (gu32*)(a->ws + WS_CTL) + CW_POOL; volatile LAS unsigned* claim = (volatile LAS unsigned*)(F.lds + MISC_OFF) + 16;
#define CLAIM(word, n) ({ __syncthreads(); if (threadIdx.x == 0) claim[0] = __hip_atomic_fetch_add(pool + 64 * (word), (unsigned)(n), RLX_AGENT); __syncthreads(); (int)claim[0]; })
#ifndef MK_CHUNK_REPS
#define MK_CHUNK_REPS 1
#endif
#define CHUNK(c) do { for (int rep_ = 0; rep_ < MK_CHUNK_REPS; ++rep_) { const Ctx Fc = fresh(F); convert_items8d(Fc, a, I_SMALL + (c) * CHUNK_ITEMS + Fc.wave * 8); } } while (0)
#ifndef MK_SCHED
#define MK_SCHED 0x00C3
#endif
#if defined(MK_RCU_PROBE)
            if ((F.vcu & 15) == 0) { const Ctx Fp = fresh(F); const f32x4* src = (const f32x4*)(a->in[21]) + (size_t)((F.vcu >> 4) * 8 + Fp.wave) * (1024 * 1024 / 16) ; f32x4 acc4 = (f32x4){0.f, 0.f, 0.f, 0.f};
                for (int i = 0; i < 1024 * 1024 / 16 / 64; i += MK_RCU_PROBE) { f32x4 t[MK_RCU_PROBE];
#pragma unroll
                    for (int u = 0; u < MK_RCU_PROBE; ++u) t[u] = src[(size_t)(i + u) * 64 + Fp.lane];
#pragma unroll
                    for (int u = 0; u < MK_RCU_PROBE; ++u) acc4 += t[u]; }
                if (acc4[0] + acc4[1] + acc4[2] + acc4[3] == 1.2345f) ((float*)(F.ws + WS_HID))[Fp.tid] = acc4[0];
                __syncthreads(); }
#endif
#ifndef MK_ROLES
#define MK_ROLES 0
#endif
#if MK_ROLES
#ifndef MK_RA
#define MK_RA 6
#endif
#ifndef MK_RB
#define MK_RB 12
#endif
#ifndef MK_RC
#define MK_RC 19
#endif
#ifndef MK_NCH
#define MK_NCH 5
#endif
#ifndef MK_NCHX
#define MK_NCHX 2
#endif
#ifndef MK_NCV
#define MK_NCV 5
#endif
            const int jx = F.vcu & 31; const bool conv_role = jx >= MK_RC;
            const int slot = conv_role ? (jx - MK_RC) % 3 : (jx < MK_RA ? 0 : jx < MK_RB ? 1 : 2);
            const int nfill = conv_role ? MK_NCV : MK_NCH + (((jx < MK_RA ? jx : jx - MK_RA) < MK_NCHX) ? 1 : 0);
            const int pair = F.vcu >> 5, b = pair >> 1, kvh = pair & 1;
            for (int s = 0; s < 4; ++s) {
                if (s >= 2 || slot == s) {
                    const bool cv = (s == 3) ? !conv_role : conv_role; const int step = s >= 2 ? 1 : nfill, lim = cv ? MTOK / 32 : nchunk;
                    for (;;) { const int i0 = cv ? CLAIM(1, step) : CLAIM(0, step); if (i0 >= lim) break;
                        for (int k = 0; k < step && i0 + k < lim; ++k) { if (cv) conv_unit(F, i0 + k, a->in[11], a->in[12], a->in[13], a->in[14]); else CHUNK(i0 + k); }
                        if (s < 2) break; }
                    __syncthreads();
                }
                if (s < 2) { const int local = (F.vcu & 31) * 2 + s, hq = kvh * 4 + (local >> 4), qb = local & 15;
                    const attn_body::bf16* Qu = WSP(attn_body::bf16, WS_RA + RA_Q) + ((size_t)(b * SEQ + qb * 256) * 512 + hq * 64);
                    const attn_body::bf16* Kh = WSP(attn_body::bf16, WS_KB) + ((size_t)b * TKV * 128 + kvh * 64);
                    const attn_body::bf16* Vh = WSP(attn_body::bf16, WS_VB) + ((size_t)b * TKV * 128 + kvh * 64);
                    attn_body::bf16* Ou = WSP(attn_body::bf16, WS_RA + RA_ZO) + ((size_t)(b * SEQ + qb * 256) * DM + hq * 64);
                    attn_body::attn_unit<8>(Qu, Kh, Vh, Ou, (char*)lds_raw + RING_OFF); }
            }
#else
#ifndef MK_SCHED_MOD
#define MK_SCHED_MOD 3
#endif
            const int sch_r = (F.vcu >> 1) % MK_SCHED_MOD, npre = ((MK_SCHED) >> (4 * sch_r)) & 3, nmid = ((MK_SCHED) >> (4 * sch_r + 2)) & 3;
            if (npre) { const int c0 = CLAIM(0, npre); for (int i = 0; i < npre && c0 + i < nchunk; ++i) CHUNK(c0 + i); }
            __syncthreads();
            const int pair = F.vcu >> 5, b = pair >> 1, kvh = pair & 1;
            for (int i = 0; i < 2; ++i) { const int local = (F.vcu & 31) * 2 + i, hq = kvh * 4 + (local >> 4), qb = local & 15;
                const attn_body::bf16* Qu = WSP(attn_body::bf16, WS_RA + RA_Q) + ((size_t)(b * SEQ + qb * 256) * 512 + hq * 64);
                const attn_body::bf16* Kh = WSP(attn_body::bf16, WS_KB) + ((size_t)b * TKV * 128 + kvh * 64);
                const attn_body::bf16* Vh = WSP(attn_body::bf16, WS_VB) + ((size_t)b * TKV * 128 + kvh * 64);
                attn_body::bf16* Ou = WSP(attn_body::bf16, WS_RA + RA_ZO) + ((size_t)(b * SEQ + qb * 256) * DM + hq * 64);
                attn_body::attn_unit<8>(Qu, Kh, Vh, Ou, (char*)lds_raw + RING_OFF);
                if (i == 0 && nmid) { const int c0 = CLAIM(0, nmid); for (int k = 0; k < nmid && c0 + k < nchunk; ++k) CHUNK(c0 + k); __syncthreads(); } }
            for (;;) { const int c0 = CLAIM(0, 3); if (c0 >= nchunk) break; for (int k = 0; k < 3 && c0 + k < nchunk; ++k) CHUNK(c0 + k); }
            for (;;) { const int u0 = CLAIM(1, 2); if (u0 >= MTOK / 32) break; for (int k = 0; k < 2 && u0 + k < MTOK / 32; ++k) conv_unit(F, u0 + k, a->in[11], a->in[12], a->in[13], a->in[14]); }
#endif
#undef CLAIM
#undef CHUNK
        } break;
        PH(4) {
            CArgs* a = FRESH_ARGS();
#if MK_PASSES > 1
            if (F.bx == 0 && F.tid == 0) { gu32* pool = (gu32*)(a->ws + WS_CTL) + CW_POOL; __hip_atomic_store(pool, 0u, RLX_AGENT); __hip_atomic_store(pool + 64, 0u, RLX_AGENT); }
#endif
            pg8::Gemm g{WSP(bf16, WS_RA + RA_ZO), WSP(bf16, WS_WOUT), MTOK, DM, DM, 1 << 30, 0};
            pg8::StaticOrder S; S.init(MTOK, DM, F.G, F.bx);
            pg8::EpiResB<false> E{a->in[0], WSP(bf16, WS_H), WSP(float, WS_MOD) + 2 * 1024, NMOD6};
            pg8::gemm_phase<pg8::EpiResB<false>, pg8::StaticOrder, false, false>(ring, g, S, E);
        } break;
        case 13: PH(5) { CArgs* a = FRESH_ARGS(); phase_norm2_router(F, a->in[7] + l * DM, WSP(float, WS_MOD) + (size_t)l * 5 * NMOD6, a->in[19] + (size_t)l * DM * NE); } break;
        case 14: PH(6) { phase_topk(F); } break;
        case 15: PH(7) {
            pg8::Gemm g{WSP(bf16, WS_XN), WSP(bf16, WS_GU) + (size_t)l * NE * 2048 * 1024, MR, 2048, DM, 8, (size_t)2048 * 1024 * 2};
            pg8::StaticOrder S; S.init(MR, 2048, F.G, F.bx);
            LAS unsigned* gl = (LAS unsigned*)(F.lds + GL_OFF); const unsigned* GOFF = WSP(unsigned, WS_GOFF);
            { int t = threadIdx.x; asm volatile("" : "+v"(t));
#pragma unroll
              for (int i = 0; i < 4; ++i) { pg8::StaticOrder S2; S2.init(MR, 2048, F.G, F.bx); pg8::Unit u; if (S2.next(i, u) && t < 256) gl[i * 256 + t] = GOFF[u.pm * 256 + t]; } }
            __syncthreads();
            pg8::EpiPair<1> E{WSP(bf16, WS_HID), 1024, 0, nullptr, 0};
            pg8::gemm_phase<pg8::EpiPair<1>, pg8::StaticOrder, true, true>(ring, g, S, E, gl);
        } break;
        case 16: PH(8) {
            pg8::Gemm g{WSP(bf16, WS_HID), WSP(bf16, WS_DN) + (size_t)l * NE * 1024 * 1024, MR, DM, 1024, 8, (size_t)1024 * 1024 * 2};
            pg8::StaticOrder S; S.init(MR, DM, F.G, F.bx);
            pg8::EpiBf16 E{WSP(bf16, WS_RA + RA_Y), 1024};
            pg8::gemm_phase<pg8::EpiBf16, pg8::StaticOrder, true, false>(ring, g, S, E);
        } break;
        PH(9) { CArgs* a = FRESH_ARGS(); phase_combine<false>(F, WSP(float, WS_MOD), a->in[6] + DM, WSP(float, WS_MOD) + (size_t)5 * NMOD6, nullptr); } break;
        PH(10) {
            pg8::Gemm g{WSP(bf16, WS_XN), WSP(bf16, WS_SCIN), MTOK, 3072, DM, 1 << 30, 0};
            pg8::StaticOrder S; S.init(MTOK, 3072, F.G, F.bx);
            pg8::EpiPair<2> E{WSP(bf16, WS_RA + RA_CX), 1024, 4, WSP(bf16, WS_RA + RA_BG), 1024};
            pg8::gemm_phase<pg8::EpiPair<2>, pg8::StaticOrder, true, false>(ring, g, S, E);
        } break;
        PH(11) { CArgs* a = FRESH_ARGS(); phase_sconv(F, a->in[17]); } break;
        PH(17) { CArgs* a = FRESH_ARGS(); phase_combine<true>(F, WSP(float, WS_MOD) + (size_t)5 * NMOD6, a->in[23], nullptr, a->out); } break;
        default: break;
        }
#if !MK_PER_PHASE
#if MK_TPROBE
        if (threadIdx.x == 0) { CArgs* a = FRESH_ARGS(); ((unsigned long long*)(a->ws + WS_CTL + 131072))[ph * 256 + blockIdx.x] = rt(); }
#endif
        if (ph + 1 < hi || MK_TPROBE || pass + 1 < MK_PASSES) { CArgs* a = FRESH_ARGS(); XcdBarrier bar; bar.bar = (unsigned*)(a->ws + WS_CTL) + CW_BAR; bar.x = xb_xcc_id(); bar.st = (volatile LAS unsigned*)((LAS unsigned char*)lds_raw + MISC_OFF) + 8;
            if (ph >= BF_SEAM0 && ph < BF_SEAM0 + BF_NSEAM && lo == 0 && hi == NPHASE) {
                const int seam = ph - BF_SEAM0;
                xcd_barrier_fill(bar, [&]() { const Ctx Fb = make_ctx(lds_raw); convert_item1(Fb, a, I_SMALL + I_MOE - BF_ITEMS + (seam * 256 + Fb.bx) * 7 + (Fb.wave - 1)); });
            } else xcd_barrier(bar);
#if MK_TPROBE
            if (threadIdx.x == 0 && blockIdx.x == 0) ((unsigned long long*)(a->ws + WS_CTL + 131072))[18 * 256 + ph + 1] = rt();
#endif
        }
#endif
    }
#if MK_TPROBE
    if (blockIdx.x == 0) { CArgs* a = FRESH_ARGS(); const unsigned long long* TS = (const unsigned long long*)(a->ws + WS_CTL + 131072);
        volatile LAS float* tmp = (volatile LAS float*)((LAS unsigned char*)lds_raw + RING_OFF);
        int t = threadIdx.x; asm volatile("" : "+v"(t));
        float Q = 0.f;
        for (int k = 0; k < 18; ++k) { if (!(((MK_TP_MASK) >> k) & 1)) continue;
            const unsigned long long s0 = TS[18 * 256 + k];
            __syncthreads(); if (t < 256) tmp[t] = (float)(long long)(TS[k * 256 + t] - s0); __syncthreads();
            if (t == 0) { float mn = 1e30f, mx = -1e30f, sm = 0.f; for (int i = 0; i < 256; ++i) { const float v = tmp[i]; mn = fminf(mn, v); mx = fmaxf(mx, v); sm += v; }
                const float nxt = (float)(long long)(TS[18 * 256 + k + 1] - s0);
                const float ev[5] = {0.f, mn, sm * (1.f / 256.f), mx, nxt};
                Q += ev[MK_TP_X] - ev[MK_TP_Y]; } }
#if MK_TPROBE == 2
        if (t == 0) Q = (float)(long long)TS[18 * 256 + 32];
#endif
        if (t == 0) { float V = 64.f * (Q * 0.01f - (float)(MK_TP_T0)) / (float)(MK_TP_FS); V = fminf(fmaxf(V, 0.f), 64.f); a->out[0] += V; } }
#endif
#undef PH
#undef WSP
}

#ifdef MK_ZERO_KERNEL
__global__ void mk_zero(v4u* p) { p[blockIdx.x * 256 + threadIdx.x] = (v4u){0u, 0u, 0u, 0u}; }
#endif
static void mk_launch(void* const* d_in, const int* in_sizes, int n_in, void* d_out, int out_size, void* d_ws, size_t ws_size, hipStream_t stream) {
    static int grid = 0;
    if (grid == 0) {
        if (n_in != 24 || in_sizes[0] != MTOK * DM || out_size != MTOK * DM || ws_size < WS_END) { fprintf(stderr, "kernel_launch: unexpected shapes / workspace (n_in %d, ws %zu, need %zu)\n", n_in, ws_size, (size_t)WS_END); grid = -1; return; }
        int dev = 0, cus = 0, per_cu = 0;
        if (hipGetDevice(&dev) != hipSuccess || hipDeviceGetAttribute(&cus, hipDeviceAttributeMultiprocessorCount, dev) != hipSuccess) { grid = -1; return; }
        if (hipFuncSetAttribute((const void*)mk_fwd, hipFuncAttributeMaxDynamicSharedMemorySize, LDS_BYTES) != hipSuccess) { fprintf(stderr, "kernel_launch: hipFuncSetAttribute failed\n"); grid = -1; return; }
        if (hipOccupancyMaxActiveBlocksPerMultiprocessor(&per_cu, (const void*)mk_fwd, NWAVES * 64, LDS_BYTES) != hipSuccess || per_cu < 1) { fprintf(stderr, "kernel_launch: occupancy query says %d blocks per CU\n", per_cu); (void)hipGetLastError(); grid = -1; return; }
        if (cus < 256) { fprintf(stderr, "kernel_launch: %d CUs, this kernel needs 256 co-resident workgroups\n", cus); grid = -1; return; }
        grid = 256;
    }
    if (grid < 0) return;
#ifdef MK_ZERO_KERNEL
    hipLaunchKernelGGL(mk_zero, dim3(CTL_ZERO_BYTES / 16 / 256), dim3(256), 0, stream, (v4u*)((char*)d_ws + WS_CTL));
#else
    if (hipMemsetAsync((char*)d_ws + WS_CTL, 0, CTL_ZERO_BYTES, stream) != hipSuccess) { fprintf(stderr, "kernel_launch: memset failed\n"); return; }
#endif
    Args a; memset(&a, 0, sizeof(a));
    for (int i = 0; i < 24; ++i) a.in[i] = (const float*)d_in[i];
    a.out = (float*)d_out; a.ws = (unsigned char*)d_ws;
#if MK_PER_PHASE
#ifndef MK_DUP_MASK
#define MK_DUP_MASK 0
#endif
    for (int p = 0; p < MK_PH_END; ++p) { a.ph_lo = p; a.ph_hi = p + 1; const int reps = ((MK_DUP_MASK >> p) & 1) ? 2 : 1;
        for (int r = 0; r < reps; ++r) hipLaunchKernelGGL(mk_fwd, dim3(grid), dim3(NWAVES * 64), LDS_BYTES, stream, a); }
#else
    a.ph_lo = 0; a.ph_hi = MK_PH_END;
    void* kargs[] = {&a};
    hipError_t e = hipLaunchCooperativeKernel((const void*)mk_fwd, dim3(grid), dim3(NWAVES * 64), kargs, LDS_BYTES, stream);
    if (e != hipSuccess) fprintf(stderr, "kernel_launch: cooperative launch failed: %s\n", hipGetErrorString(e));
#endif
}

#ifndef MK_DEBUG
extern "C" void kernel_launch(void* const* d_in, const int* in_sizes, int n_in, void* d_out, int out_size, void* d_ws, size_t ws_size, hipStream_t stream) {
    mk_launch(d_in, in_sizes, n_in, d_out, out_size, d_ws, ws_size, stream);
#ifdef MK_TWICE
    mk_launch(d_in, in_sizes, n_in, d_out, out_size, d_ws, ws_size, stream);
#endif
}
#endif
```

```cpp
#include <hip/hip_runtime.h>
#include <hip/hip_cooperative_groups.h>
#include <cstdio>
#include <cstdint>
#include <cstring>
#define MK_COOP_MARK 0
#define MK_TKN 1
namespace pg8 {
#define PG8_LAS __attribute__((address_space(3)))
typedef unsigned short bf16_t;
typedef short bf16x8 __attribute__((ext_vector_type(8)));
typedef float f32x4 __attribute__((ext_vector_type(4)));
typedef unsigned u32x4 __attribute__((ext_vector_type(4)));
constexpr int BM = 256, BK = 64, HALF = 128, HTB = HALF * BK * 2  , STAGE_BYTES = 8 * HTB, NXCD = 8, WGM = 1;

__host__ __device__ __forceinline__ int lds_byte(int r, int c) { const int st = (r >> 4) * 2 + (c >> 5), rr = r & 15, cc = c & 31, ob = rr * 64 + cc * 2; return st * 1024 + (ob ^ (((ob >> 9) & 1) << 5)); }
__host__ __device__ __forceinline__ void stage_rc(int b, int& R, int& C) { const int st = b / 1024, sb = b % 1024, swz = sb ^ (((sb >> 9) & 1) << 5); R = (st >> 1) * 16 + swz / 64; C = (st & 1) * 32 + (swz % 64) / 2; }
__host__ __device__ __forceinline__ int perm32(int rho) { const int n = rho >> 4, i = rho & 15; return 8 * (i >> 2) + 4 * n + (i & 3); }

struct Unit { int pm, pn; };
struct Gemm { const bf16_t* A; const bf16_t* Bt; int M, N, K; int pm_per_group; size_t group_stride; };

struct StaticOrder {
    int nM, nN, nwg, G, c;
    __host__ __device__ __forceinline__ void init(int M, int N, int G_, int c_) { nM = M / BM; nN = N / BM; nwg = nM * nN; G = G_; c = c_; }
    __host__ __device__ __forceinline__ bool next(int i, Unit& u) const {
        const long L = (long)i * G + c; if (L >= nwg) return false;
        int wgid = (int)L; { const int q = nwg / NXCD, r = nwg % NXCD, xcd = wgid % NXCD, off = wgid / NXCD; wgid = (xcd < r ? xcd * (q + 1) : r * (q + 1) + (xcd - r) * q) + off; }
        const int nig = WGM * nN, gid = wgid / nig, fm = gid * WGM, gsz = (nM - fm) < WGM ? (nM - fm) : WGM;
        u.pm = fm + ((wgid % nig) % gsz); u.pn = (wgid % nig) / gsz; return true;
    }
};
struct OrderL0 {
    StaticOrder so; int nlat;
    __host__ __device__ __forceinline__ void init(int G_, int c_) { so.init(16384, 1792, G_, c_); nlat = so.nwg; }
    __host__ __device__ __forceinline__ bool next(int i, Unit& u) const {
        const long L = (long)i * so.G + so.c;
        if (L < nlat) return so.next(i, u);
        if (L < nlat + 4) { u.pm = 64 + (int)(L - nlat); u.pn = 2; return true; }
        return false;
    }
};

__device__ __forceinline__ unsigned cvt_pk_bf16(float lo, float hi) { unsigned r; asm volatile("v_cvt_pk_bf16_f32 %0, %1, %2" : "=v"(r) : "v"(lo), "v"(hi)); return r; }
__device__ __forceinline__ u32x4 pack8(const f32x4 a, const f32x4 b) { u32x4 w; w.x = cvt_pk_bf16(a[0], a[1]); w.y = cvt_pk_bf16(a[2], a[3]); w.z = cvt_pk_bf16(b[0], b[1]); w.w = cvt_pk_bf16(b[2], b[3]); return w; }
__device__ __forceinline__ float fast_sigmoid(float x) { return __builtin_amdgcn_rcpf(1.0f + __builtin_amdgcn_exp2f(-1.4426950408889634f * x)); }


struct EpiBf16 {
    static constexpr bool PERM = true;
    bf16_t* O; int ldc;
    __device__ __forceinline__ void operator()(const f32x4 (&acc)[2][2][4][2], const Unit& u, int wr, int wc, int fr, int fq) const {
        const int row0 = u.pm * BM + wr * 64 + fr, col0 = u.pn * BM + wc * 32 + 8 * fq;
#pragma unroll
        for (int ai = 0; ai < 2; ++ai)
#pragma unroll
            for (int m = 0; m < 4; ++m) { bf16_t* rowp = O + (size_t)(row0 + ai * HALF + m * 16) * ldc + col0;
#pragma unroll
                for (int bj = 0; bj < 2; ++bj) *(u32x4*)(rowp + bj * HALF) = pack8(acc[ai][bj][m][0], acc[ai][bj][m][1]); }
    }
};
template <int MODE> struct EpiPair {
    static constexpr bool PERM = true;
    bf16_t* O; int ldc; int pn0; bf16_t* Oplain; int ldp;
    __device__ __forceinline__ void operator()(const f32x4 (&acc)[2][2][4][2], const Unit& u, int wr, int wc, int fr, int fq) const {
        const int row0 = u.pm * BM + wr * 64 + fr;
        if (u.pn < pn0) { EpiBf16 e{Oplain, ldp}; e(acc, u, wr, wc, fr, fq); return; }
        const int col0 = (u.pn - pn0) * HALF + wc * 32 + 8 * fq;
#pragma unroll
        for (int ai = 0; ai < 2; ++ai)
#pragma unroll
            for (int m = 0; m < 4; ++m) { f32x4 o[2];
#pragma unroll
                for (int n = 0; n < 2; ++n) { const f32x4 x = acc[ai][0][m][n], y = acc[ai][1][m][n];
#pragma unroll
                    for (int j = 0; j < 4; ++j) { if (MODE == 0) o[n][j] = x[j] * fast_sigmoid(y[j]); else if (MODE == 1) o[n][j] = x[j] * fast_sigmoid(x[j]) * y[j]; else o[n][j] = x[j] * y[j]; } }
                *(u32x4*)(O + (size_t)(row0 + ai * HALF + m * 16) * ldc + col0) = pack8(o[0], o[1]); }
    }
};
struct EpiRes {
    static constexpr bool PERM = false;
    const float* base; float* out; const float* gate; int gstride;
    __device__ __forceinline__ void operator()(const f32x4 (&acc)[2][2][4][2], const Unit& u, int wr, int wc, int fr, int fq) const {
        const int row0 = u.pm * BM + wr * 64 + fr, col0 = u.pn * BM + wc * 32 + 4 * fq; const int b = (u.pm * BM) >> 12;
        f32x4 gv[2][2];
#pragma unroll
        for (int bj = 0; bj < 2; ++bj)
#pragma unroll
            for (int n = 0; n < 2; ++n) gv[bj][n] = *(const f32x4*)(gate + (size_t)b * gstride + col0 + bj * HALF + n * 16);
#pragma unroll
        for (int ai = 0; ai < 2; ++ai) {
            f32x4 pre[4][2][2];
#pragma unroll
            for (int m = 0; m < 4; ++m) { const size_t off = (size_t)(row0 + ai * HALF + m * 16) * 1024 + col0;
#pragma unroll
                for (int bj = 0; bj < 2; ++bj)
#pragma unroll
                    for (int n = 0; n < 2; ++n) pre[m][bj][n] = *(const f32x4*)(base + off + bj * HALF + n * 16); }
            asm volatile("" ::: "memory");
#pragma unroll
            for (int m = 0; m < 4; ++m) { const size_t off = (size_t)(row0 + ai * HALF + m * 16) * 1024 + col0;
#pragma unroll
                for (int bj = 0; bj < 2; ++bj)
#pragma unroll
                    for (int n = 0; n < 2; ++n) *(f32x4*)(out + off + bj * HALF + n * 16) = pre[m][bj][n] + gv[bj][n] * acc[ai][bj][m][n]; }
            asm volatile("" ::: "memory");
        }
    }
};
template <bool BASEB> struct EpiResB {
    static constexpr bool PERM = true;
    const void* base; bf16_t* out; const float* gate; int gstride;
    __device__ __forceinline__ void operator()(const f32x4 (&acc)[2][2][4][2], const Unit& u, int wr, int wc, int fr, int fq) const {
        const int row0 = u.pm * BM + wr * 64 + fr, col0 = u.pn * BM + wc * 32 + 8 * fq; const int b = (u.pm * BM) >> 12;
        f32x4 gv[2][2];
#pragma unroll
        for (int bj = 0; bj < 2; ++bj)
#pragma unroll
            for (int n = 0; n < 2; ++n) gv[bj][n] = *(const f32x4*)(gate + (size_t)b * gstride + col0 + bj * HALF + 4 * n);
#pragma unroll
        for (int ai = 0; ai < 2; ++ai) {
            f32x4 pre[4][2][2]; u32x4 preb[4][2];
#pragma unroll
            for (int m = 0; m < 4; ++m) { const size_t off = (size_t)(row0 + ai * HALF + m * 16) * 1024 + col0;
#pragma unroll
                for (int bj = 0; bj < 2; ++bj) {
                    if (BASEB) preb[m][bj] = *(const u32x4*)((const bf16_t*)base + off + bj * HALF);
                    else { pre[m][bj][0] = *(const f32x4*)((const float*)base + off + bj * HALF); pre[m][bj][1] = *(const f32x4*)((const float*)base + off + bj * HALF + 4); } } }
            asm volatile("" ::: "memory");
#pragma unroll
            for (int m = 0; m < 4; ++m) { const size_t off = (size_t)(row0 + ai * HALF + m * 16) * 1024 + col0;
#pragma unroll
                for (int bj = 0; bj < 2; ++bj) {
                    f32x4 b0, b1;
                    if (BASEB) { const u32x4 w = preb[m][bj]; b0 = (f32x4){__builtin_bit_cast(float, w.x << 16), __builtin_bit_cast(float, w.x & 0xffff0000u), __builtin_bit_cast(float, w.y << 16), __builtin_bit_cast(float, w.y & 0xffff0000u)};
                        b1 = (f32x4){__builtin_bit_cast(float, w.z << 16), __builtin_bit_cast(float, w.z & 0xffff0000u), __builtin_bit_cast(float, w.w << 16), __builtin_bit_cast(float, w.w & 0xffff0000u)}; }
                    else { b0 = pre[m][bj][0]; b1 = pre[m][bj][1]; }
                    *(u32x4*)(out + off + bj * HALF) = pack8(b0 + gv[bj][0] * acc[ai][bj][m][0], b1 + gv[bj][1] * acc[ai][bj][m][1]); } }
            asm volatile("" ::: "memory");
        }
    }
};
struct EpiL0 {
    static constexpr bool PERM = true;
    bf16_t *Q, *KB, *VB, *G; const float *cosT, *sinT, *qg, *kg; float qscale;
    __device__ __forceinline__ void operator()(const f32x4 (&acc)[2][2][4][2], const Unit& u, int wr, int wc, int fr, int fq) const {
        if (u.pn >= 3) { EpiPair<0> e{G, 512, 3, nullptr, 0}; e(acc, u, wr, wc, fr, fq); return; }
        const bool is_ctx = u.pm >= 64; const bool is_v = (u.pn == 2) && (wc >= 2); const bool is_q = u.pn < 2;
        const int head = is_q ? (4 * u.pn + wc) : (wc & 1);
        const float* gsel = is_q ? qg : kg;
        f32x4 g1[2], g2[2];
#pragma unroll
        for (int n = 0; n < 2; ++n) { g1[n] = *(const f32x4*)(gsel + 8 * fq + 4 * n); g2[n] = *(const f32x4*)(gsel + 32 + 8 * fq + 4 * n); }
#pragma unroll
        for (int ai = 0; ai < 2; ++ai)
#pragma unroll
            for (int m = 0; m < 4; ++m) {
                const int rl = ai * HALF + wr * 64 + m * 16 + fr;
                int t; size_t kvrow, qrow = 0;
                if (!is_ctx) { const int grow = u.pm * BM + rl; const int b = grow >> 12; t = grow & 4095; kvrow = (size_t)b * 4352 + 256 + t; qrow = (size_t)grow; }
                else { const int b = u.pm - 64; t = rl; kvrow = (size_t)b * 4352 + t; }
                f32x4 x1[2] = {acc[ai][0][m][0], acc[ai][0][m][1]}, x2[2] = {acc[ai][1][m][0], acc[ai][1][m][1]};
                if (is_v) { bf16_t* p = VB + kvrow * 128 + head * 64 + 8 * fq; *(u32x4*)p = pack8(x1[0], x1[1]); *(u32x4*)(p + 32) = pack8(x2[0], x2[1]); continue; }
                float ss = 0.f;
#pragma unroll
                for (int n = 0; n < 2; ++n)
#pragma unroll
                    for (int j = 0; j < 4; ++j) ss += x1[n][j] * x1[n][j] + x2[n][j] * x2[n][j];
                { const int ln_ = fr + 16 * fq; ss += __builtin_bit_cast(float, __builtin_amdgcn_ds_bpermute((ln_ ^ 16) << 2, __builtin_bit_cast(int, ss))); ss += __builtin_bit_cast(float, __builtin_amdgcn_ds_bpermute((ln_ ^ 32) << 2, __builtin_bit_cast(int, ss))); }
                const float rstd = __builtin_amdgcn_rsqf(ss * (1.0f / 64.0f) + 1e-6f);
#pragma unroll
                for (int n = 0; n < 2; ++n) { x1[n] = x1[n] * rstd * g1[n]; x2[n] = x2[n] * rstd * g2[n]; }
                if (!is_ctx) {
#pragma unroll
                    for (int n = 0; n < 2; ++n) { const f32x4 cs = *(const f32x4*)(cosT + (size_t)t * 32 + 8 * fq + 4 * n), sn = *(const f32x4*)(sinT + (size_t)t * 32 + 8 * fq + 4 * n);
                        const f32x4 a = x1[n] * cs - x2[n] * sn, b2 = x2[n] * cs + x1[n] * sn; x1[n] = a; x2[n] = b2; }
                }
                if (is_q) { bf16_t* p = Q + qrow * 512 + head * 64 + 8 * fq; *(u32x4*)p = pack8(x1[0] * qscale, x1[1] * qscale); *(u32x4*)(p + 32) = pack8(x2[0] * qscale, x2[1] * qscale); }
                else { bf16_t* p = KB + kvrow * 128 + head * 64 + 8 * fq; *(u32x4*)p = pack8(x1[0], x1[1]); *(u32x4*)(p + 32) = pack8(x2[0], x2[1]); }
            }
    }
};

template <class E> struct EpiPrefetch { static __device__ __forceinline__ const char* tile(const E&, const Unit&, int) { return nullptr; } };
template <> struct EpiPrefetch<EpiResB<true>> {
    static __device__ __forceinline__ const char* tile(const EpiResB<true>& e, const Unit& u, int K) { return K == 1024 ? (const char*)e.base + ((size_t)u.pm * BM * 1024 + (size_t)u.pn * BM) * 2 : nullptr; } };

template <class Epi, class Sched, bool ALIGN_EPI = false, bool GATHER = false>
__device__ __forceinline__ void gemm_phase(PG8_LAS unsigned char* lds, const Gemm g, const Sched& S, const Epi& E, const PG8_LAS unsigned* gl = nullptr) {
    int tid_ = threadIdx.x; asm volatile("" : "+v"(tid_));
    const int tid = tid_, wid = __builtin_amdgcn_readfirstlane(tid >> 6), lane = tid & 63, wr = wid >> 2, wc = wid & 3, fr = lane & 15, fq = lane >> 4;
    const int K = g.K, nt = K / BK;
    const size_t kstep = (size_t)(BK * 2);
    const size_t hstep = (size_t)HALF * K * 2;
    const size_t tstep = 2 * hstep;
    unsigned voffB[2], vC0[2], vC1[2], vN0[2], vN1[2]; int gR[2]; unsigned gC[2];
#pragma unroll
    for (int i = 0; i < 2; ++i) { int R, C; stage_rc(tid * 16 + i * 8192, R, C); const int Rb = Epi::PERM ? ((R & ~31) + perm32(R & 31)) : R;
        voffB[i] = (unsigned)(Rb * K + C) * 2u; gR[i] = R; gC[i] = (unsigned)C * 2u;
        vC0[i] = (unsigned)(R * K + C) * 2u; vC1[i] = vC0[i] + (unsigned)hstep; vN0[i] = vC0[i]; vN1[i] = vC1[i]; }
    const unsigned ldsw = (unsigned)wid * 1024u;
    const int aoff = lds_byte(wr * 64 + fr, fq * 8), boff = lds_byte(wc * 32 + fr, fq * 8);
#define PG8_SA(b, h) (((b) * 2 + (h)) * HTB)
#define PG8_SB(b, h) ((4 + (b) * 2 + (h)) * HTB)
#define PG8_STAGE(bufoff, gbase, voff) do { _Pragma("unroll") for (int _i = 0; _i < 2; ++_i) \
        __builtin_amdgcn_global_load_lds((const unsigned*)((const char*)(gbase) + (voff)[_i]), (PG8_LAS unsigned*)(lds + (bufoff) + ldsw + _i * 8192), 16, 0, 0); } while (0)
#define PG8_LDA(dst, b, h) do { _Pragma("unroll") for (int m = 0; m < 4; ++m) _Pragma("unroll") for (int k = 0; k < 2; ++k) dst[m][k] = *(const PG8_LAS bf16x8*)(lds + PG8_SA(b, h) + aoff + m * 2048 + k * 1024); } while (0)
#define PG8_LDB(dst, b, h) do { _Pragma("unroll") for (int n = 0; n < 2; ++n) _Pragma("unroll") for (int k = 0; k < 2; ++k) dst[n][k] = *(const PG8_LAS bf16x8*)(lds + PG8_SB(b, h) + boff + n * 2048 + k * 1024); } while (0)
#define PG8_MMA(ai, bj, At, Bt) do { __builtin_amdgcn_s_setprio(1); _Pragma("unroll") for (int m = 0; m < 4; ++m) _Pragma("unroll") for (int n = 0; n < 2; ++n) _Pragma("unroll") for (int k = 0; k < 2; ++k) \
        acc[ai][bj][m][n] = __builtin_amdgcn_mfma_f32_16x16x32_bf16(Bt[n][k], At[m][k], acc[ai][bj][m][n], 0, 0, 0); __builtin_amdgcn_s_setprio(0); } while (0)
#define PG8_WAIT_V(n) asm volatile("s_waitcnt vmcnt(" #n ")" ::: "memory")
#define PG8_WAIT_L(n) asm volatile("s_waitcnt lgkmcnt(" #n ")" ::: "memory")
#define PG8_BAR __builtin_amdgcn_s_barrier()
#define PG8_SCHED __builtin_amdgcn_sched_barrier(0)
#define PG8_GLOAD(d0, d1, u_) do { _Pragma("unroll") for (int _i = 0; _i < 2; ++_i) { d0[_i] = gl[(u_) * 256 + gR[_i]] + gC[_i]; d1[_i] = gl[(u_) * 256 + HALF + gR[_i]] + gC[_i]; } } while (0)
#define PG8_APTR(u_) (GATHER ? (const char*)g.A : (const char*)g.A + (size_t)(u_).pm * tstep)
#define PG8_BPTR(u_) ((const char*)g.Bt + (size_t)((u_).pm / g.pm_per_group) * g.group_stride + (size_t)(u_).pn * tstep)
    Unit cur, nxt; int ui = 0;
    if (!S.next(0, cur)) return;
    f32x4 acc[2][2][4][2];
#pragma unroll
    for (int a = 0; a < 2; ++a)
#pragma unroll
        for (int b = 0; b < 2; ++b)
#pragma unroll
            for (int m = 0; m < 4; ++m)
#pragma unroll
                for (int n = 0; n < 2; ++n) acc[a][b][m][n] = (f32x4){0.f, 0.f, 0.f, 0.f};
    bf16x8 At[4][2], B0[2][2], B1[2][2];
    const char* cA = PG8_APTR(cur); const char* cB = PG8_BPTR(cur);
    if constexpr (GATHER) { PG8_GLOAD(vC0, vC1, 0); }
    PG8_STAGE(PG8_SB(0, 0), cB, voffB); PG8_STAGE(PG8_SB(0, 1), cB + hstep, voffB); PG8_STAGE(PG8_SA(0, 0), cA, vC0); PG8_STAGE(PG8_SA(0, 1), cA, vC1);
    if (wr == 1) PG8_BAR;
    PG8_WAIT_V(2); PG8_BAR;
    PG8_STAGE(PG8_SB(1, 0), cB + kstep, voffB); PG8_STAGE(PG8_SA(1, 0), cA + kstep, vC0); PG8_STAGE(PG8_SB(1, 1), cB + hstep + kstep, voffB);
    PG8_WAIT_V(6); PG8_BAR;
    for (;;) {
        const bool has_next = S.next(ui + 1, nxt);
        const char* pf_ = (!GATHER && !has_next) ? EpiPrefetch<Epi>::tile(E, cur, K) : nullptr;
        const char* nA = has_next ? PG8_APTR(nxt) : (pf_ ? pf_ : cA); const char* nB = has_next ? PG8_BPTR(nxt) : (pf_ ? pf_ + 2 * kstep : cB);
        for (int t = 0; t < nt; t += 2) {
            const bool last = (t == nt - 2);
            const char* a1 = cA + (size_t)(t + 1) * kstep;
            const char* a2 = last ? nA : cA + (size_t)(t + 2) * kstep; const char* b2 = last ? nB : cB + (size_t)(t + 2) * kstep;
            const char* a3 = a2 + kstep; const char* b3 = b2 + kstep;
            unsigned vX0[2], vX1[2];
            if constexpr (GATHER) {
                if (last) { if (has_next) { PG8_GLOAD(vN0, vN1, ui + 1); } else { vN0[0] = vC0[0]; vN0[1] = vC0[1]; vN1[0] = vC1[0]; vN1[1] = vC1[1]; } }
                vX0[0] = last ? vN0[0] : vC0[0]; vX0[1] = last ? vN0[1] : vC0[1]; vX1[0] = last ? vN1[0] : vC1[0]; vX1[1] = last ? vN1[1] : vC1[1];
            } else { vX0[0] = vC0[0]; vX0[1] = vC0[1]; vX1[0] = vC1[0]; vX1[1] = vC1[1]; }
            PG8_LDB(B0, 0, 0); PG8_LDB(B1, 0, 1); PG8_SCHED; PG8_LDA(At, 0, 0); PG8_STAGE(PG8_SA(1, 1), a1, vC1);
            PG8_WAIT_V(8); PG8_WAIT_L(0); PG8_BAR; PG8_MMA(0, 0, At, B0); PG8_MMA(0, 1, At, B1); PG8_BAR; PG8_SCHED;
            PG8_LDA(At, 0, 1); PG8_STAGE(PG8_SB(0, 0), b2, voffB); PG8_STAGE(PG8_SB(0, 1), b2 + hstep, voffB); PG8_STAGE(PG8_SA(0, 0), a2, vX0);
            PG8_WAIT_V(8); PG8_WAIT_L(0); PG8_BAR; PG8_MMA(1, 0, At, B0); PG8_MMA(1, 1, At, B1); PG8_BAR; PG8_SCHED;
            PG8_LDB(B0, 1, 0); PG8_LDB(B1, 1, 1); PG8_SCHED; PG8_LDA(At, 1, 0); PG8_STAGE(PG8_SA(0, 1), a2, vX1);
            PG8_WAIT_V(8); PG8_WAIT_L(0); PG8_BAR; PG8_MMA(0, 0, At, B0); PG8_MMA(0, 1, At, B1); PG8_BAR; PG8_SCHED;
            PG8_LDA(At, 1, 1); PG8_STAGE(PG8_SB(1, 0), b3, voffB); PG8_STAGE(PG8_SB(1, 1), b3 + hstep, voffB); PG8_STAGE(PG8_SA(1, 0), a3, vX0);
            PG8_WAIT_V(8); PG8_WAIT_L(0); PG8_BAR; PG8_MMA(1, 0, At, B0); PG8_MMA(1, 1, At, B1); PG8_BAR; PG8_SCHED;
        }
        if constexpr (ALIGN_EPI) { if (wr == 0) PG8_BAR; }
        { int fr_e = fr, fq_e = fq; asm volatile("" : "+v"(fr_e), "+v"(fq_e));
          E(acc, cur, wr, wc, fr_e, fq_e); }
        if (!has_next) break;
#pragma unroll
        for (int a = 0; a < 2; ++a)
#pragma unroll
            for (int b = 0; b < 2; ++b)
#pragma unroll
                for (int m = 0; m < 4; ++m)
#pragma unroll
                    for (int n = 0; n < 2; ++n) acc[a][b][m][n] = (f32x4){0.f, 0.f, 0.f, 0.f};
        cur = nxt; cA = nA; cB = nB; ++ui;
        if constexpr (GATHER) { vC0[0] = vN0[0]; vC0[1] = vN0[1]; vC1[0] = vN1[0]; vC1[1] = vN1[1]; }
        if constexpr (ALIGN_EPI) { if (wr == 1) PG8_BAR; }
    }
    PG8_WAIT_V(0);
    if constexpr (!ALIGN_EPI) { if (wr == 0) PG8_BAR; }
    PG8_BAR;
#undef PG8_SA
#undef PG8_SB
#undef PG8_STAGE
#undef PG8_LDA
#undef PG8_LDB
#undef PG8_MMA
#undef PG8_WAIT_V
#undef PG8_WAIT_L
#undef PG8_BAR
#undef PG8_SCHED
#undef PG8_GLOAD
#undef PG8_APTR
#undef PG8_BPTR
}
}
#include <hip/hip_bf16.h>
namespace attn_body {
using bf16=__hip_bfloat16;
using bf16x8=__attribute__((ext_vector_type(8)))short;
using s16x4=__attribute__((ext_vector_type(4)))short;
using f32x16=__attribute__((ext_vector_type(16)))float;
using u32x4=__attribute__((ext_vector_type(4)))unsigned;
constexpr int D=64,QP=512,KP=128,OP=1024,NKT=68;
constexpr int NW=8,QBLK=32,QB=QBLK*NW,KVBLK=64;
__device__ __forceinline__ int crow(int r,int hi){return (r&3)+8*(r>>2)+4*hi;}
#define SBAR() __builtin_amdgcn_sched_barrier(0)
constexpr int NSLOT=3, SLOTB=8192;
constexpr int LDS_K=0, LDS_V=NSLOT*SLOTB, LDS_WS=2*NSLOT*SLOTB, LDS_OST=LDS_WS+NW*64*4, LDS_BYTES=LDS_OST+NW*4096;
constexpr float C2=0.125f*1.4426950408889634f;
__device__ __forceinline__ void glds16(const void*gsrc,unsigned lds_dst){unsigned keep;
  asm volatile("s_mov_b32 %0, m0\n\ts_mov_b32 m0, %2\n\ts_nop 0\n\tglobal_load_lds_dwordx4 %1, off\n\ts_mov_b32 m0, %0":"=&s"(keep):"v"(gsrc),"s"(lds_dst):"memory");}
__device__ __forceinline__ float max3f(float a,float b,float c){float r;asm("v_max3_f32 %0, %1, %2, %3":"=v"(r):"v"(a),"v"(b),"v"(c));return r;}
__device__ __forceinline__ float max2f(float a,float b){float r;asm("v_max_f32_e32 %0, %1, %2":"=v"(r):"v"(a),"v"(b));return r;}
__device__ __forceinline__ float fadd_s(float a,float b){float r;asm("v_add_f32_e32 %0, %1, %2":"=v"(r):"v"(a),"v"(b));return r;}
__device__ __forceinline__ float fsub_s(float a,float b){float r;asm("v_sub_f32_e32 %0, %1, %2":"=v"(r):"v"(a),"v"(b));return r;}
typedef float f32x2_t __attribute__((ext_vector_type(2))); typedef __bf16 bf16x2_t __attribute__((ext_vector_type(2)));
__device__ __forceinline__ unsigned cvtpk_s(float lo,float hi){f32x2_t v={lo,hi};bf16x2_t b=__builtin_convertvector(v,bf16x2_t);return __builtin_bit_cast(unsigned,b);}
#define WAIT_BAR(N) asm volatile("s_waitcnt vmcnt(" #N ") lgkmcnt(0)\n\ts_barrier":::"memory")

__device__ __forceinline__ void qkt(f32x16&p0,f32x16&p1,const char*Kslot,const bf16x8*qr,const f32x16&negm,int r32,int hi){
  const char*kb=Kslot+hi*1024+r32*16;
  #pragma unroll
  for(int d0=0;d0<4;++d0){
    const bf16x8 b0=*reinterpret_cast<const bf16x8*>(kb+d0*2048);
    const bf16x8 b1=*reinterpret_cast<const bf16x8*>(kb+d0*2048+512);
    if(d0==0){p0=__builtin_amdgcn_mfma_f32_32x32x16_bf16(b0,qr[0],negm,0,0,0);p1=__builtin_amdgcn_mfma_f32_32x32x16_bf16(b1,qr[0],negm,0,0,0);}
    else{p0=__builtin_amdgcn_mfma_f32_32x32x16_bf16(b0,qr[d0],p0,0,0,0);p1=__builtin_amdgcn_mfma_f32_32x32x16_bf16(b1,qr[d0],p1,0,0,0);}}
}
typedef __attribute__((address_space(3))) const char* lds_cptr;
typedef short v4i16_t __attribute__((ext_vector_type(4)));
__device__ __forceinline__ void kload8(bf16x8*kf,lds_cptr kp){
  kf[0]=*(const __attribute__((address_space(3))) bf16x8*)(kp);      kf[1]=*(const __attribute__((address_space(3))) bf16x8*)(kp+512);
  kf[2]=*(const __attribute__((address_space(3))) bf16x8*)(kp+2048); kf[3]=*(const __attribute__((address_space(3))) bf16x8*)(kp+2560);
  kf[4]=*(const __attribute__((address_space(3))) bf16x8*)(kp+4096); kf[5]=*(const __attribute__((address_space(3))) bf16x8*)(kp+4608);
  kf[6]=*(const __attribute__((address_space(3))) bf16x8*)(kp+6144); kf[7]=*(const __attribute__((address_space(3))) bf16x8*)(kp+6656);
}
__device__ __forceinline__ void kload2(bf16x8*kf,lds_cptr kp,int j){ kf[2*j]=*(const __attribute__((address_space(3))) bf16x8*)(kp+j*2048); kf[2*j+1]=*(const __attribute__((address_space(3))) bf16x8*)(kp+j*2048+512); }
__device__ __forceinline__ s16x4 vtr(lds_cptr p){ return __builtin_bit_cast(s16x4,__builtin_amdgcn_ds_read_tr16_b64_v4i16((__attribute__((address_space(3))) v4i16_t*)p)); }
__device__ __forceinline__ float rowmax(const f32x16&p0,const f32x16&p1){
  float a=max3f(p0[0],p0[1],p1[0]),b=max3f(p0[2],p0[3],p1[1]);a=max3f(a,p1[2],p1[3]);
  #pragma unroll
  for(int r=4;r<16;r+=4){a=max3f(a,p0[r],p0[r+1]);b=max3f(b,p0[r+2],p0[r+3]);a=max3f(a,p1[r],p1[r+1]);b=max3f(b,p1[r+2],p1[r+3]);}
  const float m=max2f(a,b);
  auto rr=__builtin_amdgcn_permlane32_swap(__float_as_uint(m),__float_as_uint(m),false,false);
  return max2f(__uint_as_float(rr[0]),__uint_as_float(rr[1]));
}
__device__ __forceinline__ void pv(f32x16*o,int vb,bf16x8 pa0,bf16x8 pa1,bf16x8 pa2,bf16x8 pa3){
  #pragma unroll
  for(int d0=0;d0<2;++d0){s16x4 lo[4],hi[4];
    #pragma unroll
    for(int ks=0;ks<4;++ks){
      asm volatile("ds_read_b64_tr_b16 %0,%1 offset:%c2":"=&v"(lo[ks]):"v"(vb),"i"(d0*4096+ks*1024):"memory");
      asm volatile("ds_read_b64_tr_b16 %0,%1 offset:%c2":"=&v"(hi[ks]):"v"(vb),"i"(d0*4096+ks*1024+512):"memory");}
    asm volatile("s_waitcnt lgkmcnt(0)":::"memory");SBAR();
    #define PK(k) (bf16x8){lo[k][0],lo[k][1],lo[k][2],lo[k][3],hi[k][0],hi[k][1],hi[k][2],hi[k][3]}
    o[d0]=__builtin_amdgcn_mfma_f32_32x32x16_bf16(pa0,PK(0),o[d0],0,0,0);
    o[d0]=__builtin_amdgcn_mfma_f32_32x32x16_bf16(pa1,PK(1),o[d0],0,0,0);
    o[d0]=__builtin_amdgcn_mfma_f32_32x32x16_bf16(pa2,PK(2),o[d0],0,0,0);
    o[d0]=__builtin_amdgcn_mfma_f32_32x32x16_bf16(pa3,PK(3),o[d0],0,0,0);
    #undef PK
  }
}

#define ATTN_STORE16(p,v) (*(u32x4*)(p)=(v))
template<int THRL> __device__ __forceinline__ void attn_unit(const bf16*Qu,const bf16*__restrict__ Kh,const bf16*__restrict__ Vh,bf16*Ou,char*shm){
  int tid_=threadIdx.x; asm volatile("":"+v"(tid_)); const int tid=tid_,lane=tid&63,r32=lane&31,hi=lane>>5; const int wid=__builtin_amdgcn_readfirstlane(tid>>6);
  const bf16*Qw=Qu+(long)(wid*QBLK)*QP;
  const unsigned lds0=(unsigned)(uintptr_t)shm;
  float*wsf=(float*)(shm+LDS_WS)+wid*64;
  const bf16*ksrc=Kh+(long)lane*KP+wid*8;
  const bf16*vsrc=Vh+(long)(16*(wid&3)+(lane>>2))*KP+(wid>>2)*32+(lane&3)*8;
  const unsigned kdst=lds0+LDS_K+wid*1024, vdst=lds0+LDS_V+wid*1024;
  #define DMA_K(t,slot) glds16(ksrc+(long)(t)*KVBLK*KP,(unsigned)__builtin_amdgcn_readfirstlane(kdst+(slot)))
  #define DMA_V(t,slot) glds16(vsrc+(long)(t)*KVBLK*KP,(unsigned)__builtin_amdgcn_readfirstlane(vdst+(slot)))
  const int vb0=(int)(lds0+LDS_V)+((lane>>4)&1)*32+(lane&3)*8+(4*hi+((lane&15)>>2))*64;
  const char*Kbase=shm+LDS_K; bf16x8 kf[8];
  const lds_cptr shm3=(lds_cptr)shm; const lds_cptr kp0=shm3+LDS_K+hi*1024+r32*16; const lds_cptr vp0=shm3+LDS_V+((lane>>4)&1)*32+(lane&3)*8+(4*hi+((lane&15)>>2))*64;
  constexpr int NT=NKT;
  DMA_K(0,0);DMA_V(0,0);DMA_K(1,SLOTB);
  bf16x8 qr[4];
  #pragma unroll
  for(int d0=0;d0<4;++d0)qr[d0]=*reinterpret_cast<const bf16x8*>(&Qw[(long)r32*QP+d0*16+hi*8]);
  float mhat=0.f,l_reg=0.f;f32x16 o[2];o[0]=f32x16{};o[1]=f32x16{};f32x16 negm=f32x16{};asm volatile("":"+v"(negm));
  #define CMASK(P0,P1,t) do{}while(0)
  bool resc=false;
  #define START(P0,P1) do{ const float rm=rowmax(P0,P1); resc=false; \
    { const float dl=rm; mhat=fadd_s(mhat,dl); \
      _Pragma("unroll") for(int r=0;r<16;++r){P0[r]=fsub_s(P0[r],dl);P1[r]=fsub_s(P1[r],dl);} \
      _Pragma("unroll") for(int r=0;r<16;++r)negm[r]=-mhat; asm volatile("":"+v"(negm)); } \
    _Pragma("unroll") for(int r=0;r<16;++r)P0[r]=__builtin_amdgcn_exp2f(P0[r]); }while(0)
  #define RESC() do{ if(resc){ asm volatile("s_waitcnt lgkmcnt(0)":::"memory"); \
      _Pragma("unroll") for(int d_=0;d_<2;++d_) _Pragma("unroll") for(int r=0;r<16;++r)o[d_][r]*=wsf[crow(r,hi)]; } }while(0)
  f32x16 pA0,pA1,pB0,pB1;
  int sl_prev=0,sl_cur=0,sl_next=SLOTB;
  #define ROT() do{sl_prev=sl_cur;sl_cur=sl_next;sl_next=(sl_next==(NSLOT-1)*SLOTB)?0:sl_next+SLOTB;}while(0)
  DMA_K(2,2*SLOTB);
  WAIT_BAR(3);
  qkt(pA0,pA1,Kbase,qr,negm,r32,hi);asm volatile("s_nop 15\n\ts_nop 7":"+v"(pA0),"+v"(pA1));CMASK(pA0,pA1,0);
  START(pA0,pA1);
  _Pragma("unroll") for(int r=0;r<16;++r)pA1[r]=__builtin_amdgcn_exp2f(pA1[r]);
  WAIT_BAR(0);
  DMA_K(3,0);DMA_V(1,SLOTB);
  ROT();
  kload8(kf,kp0+sl_cur);
  WAIT_BAR(2);
  s16x4 vlo[8],vhi[8]; u32x4 pw0,pw1,pw2,pw3;
  #define PKW(P,B) cvtpk_s(P[B],P[B+1])
  #define PAF(k) __builtin_bit_cast(bf16x8,pw##k)
  #define VFR(i) (bf16x8){vlo[i][0],vlo[i][1],vlo[i][2],vlo[i][3],vhi[i][0],vhi[i][1],vhi[i][2],vhi[i][3]}
  #define PIN(x) asm volatile("":"+v"(x))
  #define MX3(a,b,c) __builtin_fmaxf(__builtin_fmaxf((a),(b)),(c))
  #define GAPA(MF,A0,A1,A2,A3,W0,W1,PW) do{ MF; sacc+=A0; sacc+=A1; sacc+=A2; sacc+=A3; PIN(sacc); W0; W1; PIN(PW); SBAR(); }while(0)
  #define EX(v) __builtin_amdgcn_exp2f(v)
  #define GAPB(MF,X,B) do{ MF; X[B]=EX(X[B]); X[B+1]=EX(X[B+1]); X[B+2]=EX(X[B+2]); X[B+3]=EX(X[B+3]); PIN(X); SBAR(); }while(0)
  #define VRD(i) do{ vlo[i]=vtr(vp_+(((i)>>2)*4096+((i)&3)*1024)); vhi[i]=vtr(vp_+(((i)>>2)*4096+((i)&3)*1024+512)); }while(0)
  #define KRD(G,j) do{ if(G){ kload2(kf,kp0+sl_next,j); SBAR(); } }while(0)
  #define STEP(C0,C1,P0,P1,t,GK,GV,GL) do{ SBAR(); \
    const lds_cptr vp_=vp0+sl_prev; \
    VRD(0); SBAR(); float sacc=(P0[0]+P0[1]); \
    GAPA(C0=__builtin_amdgcn_mfma_f32_32x32x16_bf16(kf[0],qr[0],negm,0,0,0), P0[2],P0[3],P0[4],P0[5],     pw0[0]=PKW(P0,0), pw0[1]=PKW(P0,2), pw0); \
    VRD(4); SBAR(); GAPA(C1=__builtin_amdgcn_mfma_f32_32x32x16_bf16(kf[1],qr[0],negm,0,0,0), P0[6],P0[7],P0[8],P0[9],     pw0[2]=PKW(P0,4), pw0[3]=PKW(P0,6), pw0); \
    VRD(1); SBAR(); GAPA(C0=__builtin_amdgcn_mfma_f32_32x32x16_bf16(kf[2],qr[1],C0,0,0,0),   P0[10],P0[11],P0[12],P0[13], pw1[0]=PKW(P0,8), pw1[1]=PKW(P0,10), pw1); \
    VRD(5); SBAR(); GAPA(C1=__builtin_amdgcn_mfma_f32_32x32x16_bf16(kf[3],qr[1],C1,0,0,0),   P0[14],P0[15],P1[0],P1[1],   pw1[2]=PKW(P0,12),pw1[3]=PKW(P0,14), pw1); \
    VRD(2); SBAR(); GAPA(C0=__builtin_amdgcn_mfma_f32_32x32x16_bf16(kf[4],qr[2],C0,0,0,0),   P1[2],P1[3],P1[4],P1[5],     pw2[0]=PKW(P1,0), pw2[1]=PKW(P1,2), pw2); \
    VRD(6); SBAR(); GAPA(C1=__builtin_amdgcn_mfma_f32_32x32x16_bf16(kf[5],qr[2],C1,0,0,0),   P1[6],P1[7],P1[8],P1[9],     pw2[2]=PKW(P1,4), pw2[3]=PKW(P1,6), pw2); \
    VRD(3); SBAR(); GAPA(C0=__builtin_amdgcn_mfma_f32_32x32x16_bf16(kf[6],qr[3],C0,0,0,0),   P1[10],P1[11],P1[12],P1[13], pw3[0]=PKW(P1,8), pw3[1]=PKW(P1,10), pw3); \
    VRD(7); SBAR(); GAPA(C1=__builtin_amdgcn_mfma_f32_32x32x16_bf16(kf[7],qr[3],C1,0,0,0),   P1[14],P1[15],0.f,0.f,       pw3[2]=PKW(P1,12),pw3[3]=PKW(P1,14), pw3); \
    l_reg+=sacc; \
    if(GK){DMA_K((t)+3,sl_cur);} if(GV){DMA_V((t)+1,sl_next);} \
    CMASK(C0,C1,t); \
    { float a=MX3(C0[0],C0[1],C1[0]),b=MX3(C0[2],C0[3],C1[1]); a=MX3(a,C1[2],C1[3]); \
      _Pragma("unroll") for(int r=4;r<16;r+=4){a=MX3(a,C0[r],C0[r+1]);b=MX3(b,C0[r+2],C0[r+3]);a=MX3(a,C1[r],C1[r+1]);b=MX3(b,C1[r+2],C1[r+3]);} \
      float rm=__builtin_fmaxf(a,b); { auto rr=__builtin_amdgcn_permlane32_swap(__float_as_uint(rm),__float_as_uint(rm),false,false); rm=__builtin_fmaxf(__uint_as_float(rr[0]),__uint_as_float(rr[1])); } \
      resc=false; \
      if(__builtin_expect(__any(rm>(float)THRL),0)){ const float dl=__builtin_fmaxf(rm,0.f); mhat+=dl; \
        _Pragma("unroll") for(int r=0;r<16;++r){C0[r]-=dl;C1[r]-=dl;} \
        _Pragma("unroll") for(int r=0;r<16;++r)negm[r]=-mhat; asm volatile("":"+v"(negm)); \
        const float f=__builtin_amdgcn_exp2f(-dl); l_reg*=f; if(hi==0)wsf[r32]=f; resc=true; } } \
    SBAR(); \
    GAPB(o[0]=__builtin_amdgcn_mfma_f32_32x32x16_bf16(PAF(0),VFR(0),o[0],0,0,0), C0,0); \
    GAPB(o[1]=__builtin_amdgcn_mfma_f32_32x32x16_bf16(PAF(0),VFR(4),o[1],0,0,0), C0,4); \
    KRD(GL,0); GAPB(o[0]=__builtin_amdgcn_mfma_f32_32x32x16_bf16(PAF(1),VFR(1),o[0],0,0,0), C0,8); \
    KRD(GL,1); GAPB(o[1]=__builtin_amdgcn_mfma_f32_32x32x16_bf16(PAF(1),VFR(5),o[1],0,0,0), C0,12); \
    KRD(GL,2); GAPB(o[0]=__builtin_amdgcn_mfma_f32_32x32x16_bf16(PAF(2),VFR(2),o[0],0,0,0), C1,0); \
    KRD(GL,3); GAPB(o[1]=__builtin_amdgcn_mfma_f32_32x32x16_bf16(PAF(2),VFR(6),o[1],0,0,0), C1,4); \
    GAPB(o[0]=__builtin_amdgcn_mfma_f32_32x32x16_bf16(PAF(3),VFR(3),o[0],0,0,0), C1,8); \
    GAPB(o[1]=__builtin_amdgcn_mfma_f32_32x32x16_bf16(PAF(3),VFR(7),o[1],0,0,0), C1,12); \
    }while(0)
  int t=1;
  #undef CMASK
  #define CMASK(P0,P1,t) do{}while(0)
  for(;t+5<NT;t+=2){
    STEP(pB0,pB1,pA0,pA1,t,true,true,true);     WAIT_BAR(2); RESC(); ROT();
    STEP(pA0,pA1,pB0,pB1,t+1,true,true,true);   WAIT_BAR(2); RESC(); ROT();
  }
  #undef CMASK
  #define CMASK(P0,P1,t) do{}while(0)
  #define ENDW(tt) do{ if((tt)+3<NT){WAIT_BAR(2);} else if((tt)+2<NT){WAIT_BAR(1);} else {WAIT_BAR(0);} }while(0)
  for(;t+1<NT;t+=2){
    STEP(pB0,pB1,pA0,pA1,t,(t+3<NT),(t+1<NT),(t+1<NT));       ENDW(t);   RESC(); ROT();
    STEP(pA0,pA1,pB0,pB1,t+1,(t+4<NT),(t+2<NT),(t+2<NT));     ENDW(t+1); RESC(); ROT();
  }
  STEP(pB0,pB1,pA0,pA1,NT-1,false,false,false); RESC();
  { float sacc=pB0[0]+pB0[1]; _Pragma("unroll") for(int r=2;r<16;++r)sacc+=pB0[r]; _Pragma("unroll") for(int r=0;r<16;++r)sacc+=pB1[r]; l_reg+=sacc;
    pw0=(u32x4){PKW(pB0,0),PKW(pB0,2),PKW(pB0,4),PKW(pB0,6)};pw1=(u32x4){PKW(pB0,8),PKW(pB0,10),PKW(pB0,12),PKW(pB0,14)};pw2=(u32x4){PKW(pB1,0),PKW(pB1,2),PKW(pB1,4),PKW(pB1,6)};pw3=(u32x4){PKW(pB1,8),PKW(pB1,10),PKW(pB1,12),PKW(pB1,14)};
    SBAR(); pv(o,vb0+sl_cur,PAF(0),PAF(1),PAF(2),PAF(3)); }
  #undef PKW
  #undef PAF
  #undef VFR
  #undef PIN
  #undef MX3
  #undef GAPA
  #undef GAPB
  #undef EX
  #undef VRD
  #undef KRD
  #undef STEP
  #undef ENDW
  {auto rr=__builtin_amdgcn_permlane32_swap(__float_as_uint(l_reg),__float_as_uint(l_reg),false,false);l_reg=__uint_as_float(rr[0])+__uint_as_float(rr[1]);}
  if(hi==0)wsf[32+r32]=l_reg;asm volatile("s_waitcnt lgkmcnt(0)":::"memory");
  float rli[16];
  #pragma unroll
  for(int r=0;r<16;++r)rli[r]=__builtin_amdgcn_rcpf(wsf[32+crow(r,hi)]);
  bf16*Ow=Ou+(long)(wid*QBLK)*OP;
  { bf16*stg=(bf16*)(shm+LDS_OST)+wid*2048;
    #pragma unroll
    for(int r=0;r<16;++r){const int orow=crow(r,hi);
      #pragma unroll
      for(int d0=0;d0<2;++d0)stg[orow*64+d0*32+r32]=__float2bfloat16(o[d0][r]*rli[r]);}
    asm volatile("s_waitcnt lgkmcnt(0)":::"memory");
    #pragma unroll
    for(int i=0;i<4;++i){const int row=i*8+(lane>>3),ch=lane&7; const u32x4 v=*(const u32x4*)(stg+row*64+ch*8); ATTN_STORE16(Ow+(long)row*OP+ch*8,v);} }
  asm volatile("s_waitcnt lgkmcnt(0)\n\ts_barrier":::"memory");
  #undef DMA_K
  #undef DMA_V
  #undef CMASK
  #undef START
  #undef RESC
  #undef ROT
}
#undef SBAR
#undef WAIT_BAR
}
constexpr int NWAVES = 8;
constexpr int DM = 1024, NB = 4, SEQ = 4096, CTXL = 256, TKV = 4352, MTOK = 16384, EIN = 1792, NE = 16, CAP = 512, MR = 32768, NMOD6 = 6144;
constexpr float EPSN = 1e-6f;
constexpr int NPHASE = 18;
#ifndef MK_COOP_MARK
#define MK_COOP_MARK 1
#endif
#ifndef MK_COMB4
#define MK_COMB4 1
#endif
#ifndef MK_TP_ARR
#define MK_TP_ARR -1
#endif
#ifndef MK_CVMAP
#define MK_CVMAP 0
#endif
#ifndef MK_N2_ALL8
#define MK_N2_ALL8 1
#endif
#ifndef MK_N2_AF32
#define MK_N2_AF32 1
#endif
#ifndef MK_N2_LATE
#define MK_N2_LATE 0
#endif
#ifndef MK_BSET
#define MK_BSET 1
#endif
#ifndef MK_TKT
#define MK_TKT 1
#endif
#ifndef MK_P0_BAL
#define MK_P0_BAL 1
#endif
#ifndef MK_TPROBE
#define MK_TPROBE 0
#endif
#if MK_TPROBE
#define TP_STAMP(F, slot) do { if (threadIdx.x == 0) ((unsigned long long*)((F).ws + WS_CTL + 131072))[(20 + (slot)) * 256 + blockIdx.x] = rt(); } while (0)
#else
#define TP_STAMP(F, slot) do { } while (0)
#endif
#ifndef MK_PER_PHASE
#define MK_PER_PHASE 0
#endif
#ifndef MK_PH_END
#define MK_PH_END NPHASE
#endif

constexpr size_t MiB = 1u << 20;
constexpr size_t WS_CTL = 0, CTL_ZERO_BYTES = 64 * 1024;
constexpr size_t WS_MOD = 1 * MiB, WS_ROPE = 2 * MiB, WS_AFF = 3 * MiB, WS_INV = 4 * MiB, WS_GV = 5 * MiB, WS_GOFF = 5 * MiB + 256 * 1024;
constexpr size_t WS_WIN = 6 * MiB, WS_WOUT = 10 * MiB, WS_SCIN = 12 * MiB, WS_SCOUT = 18 * MiB, WS_GU = 20 * MiB, WS_DN = 148 * MiB;
constexpr size_t WS_XN = 212 * MiB, WS_KB = 246 * MiB, WS_VB = 251 * MiB, WS_RA = 256 * MiB, WS_H = 320 * MiB, WS_HID = 384 * MiB, WS_END = 448 * MiB;
constexpr size_t RA_Q = 0, RA_G = 16 * MiB, RA_ZO = 32 * MiB, RA_Y = 0, RA_BG = 0, RA_CX = 32 * MiB;
constexpr int CW_BAR = 4096;
constexpr int CW_MODCNT = 7936;
constexpr int CW_POOL = 8192;

constexpr int RING_OFF = 0, RING_BYTES = 131072;
constexpr int LDSCTL_OFF = RING_BYTES, MISC_OFF = LDSCTL_OFF + 320, GL_OFF = LDSCTL_OFF + 1024;
constexpr int LDS_BYTES = 147456;
static_assert(GL_OFF + 4096 <= LDS_BYTES, "LDS map");

#define GAS __attribute__((address_space(1)))
#define LAS __attribute__((address_space(3)))
typedef unsigned short bf16;
typedef unsigned v4u __attribute__((ext_vector_type(4)));
typedef float f32x4 __attribute__((ext_vector_type(4)));
typedef short bf16x8 __attribute__((ext_vector_type(8)));
typedef GAS unsigned gu32;
typedef GAS unsigned long long gu64;
#define RLX_AGENT __ATOMIC_RELAXED, __HIP_MEMORY_SCOPE_AGENT
#define LDS_WAIT() asm volatile("s_waitcnt lgkmcnt(0)" ::: "memory")
#define VM_WAIT() asm volatile("s_waitcnt vmcnt(0)" ::: "memory")
__device__ __forceinline__ unsigned long long rt() { return __builtin_amdgcn_s_memrealtime(); }
__device__ __forceinline__ unsigned f2bf(float f) { unsigned u = __builtin_bit_cast(unsigned, f); return (u + 0x7fffu + ((u >> 16) & 1u)) >> 16; }
__device__ __forceinline__ unsigned pk2(float lo, float hi) { return f2bf(lo) | (f2bf(hi) << 16); }

#define XB_TMO      128
#define XB_XCNT(j)  (256  + 64 * (j))
#define XB_XSUB(j)  (1280 + 64 * (j))
#define XB_XGEN(j)  (2304 + 64 * (j))
#define XB_TOP      3328
#define XB_TOPGEN   3392
#define XCD_BAR_WORDS 3456
#define XB_SPIN_CAP (1u << 18)
#ifndef XB_EARLY_WB
#define XB_EARLY_WB 0
#endif
#ifndef XB_TOPPOLL
#define XB_TOPPOLL 1
#endif
#ifndef XB_FLAT_REL
#define XB_FLAT_REL 0
#endif
#ifndef XB_EARLY_INV
#define XB_EARLY_INV 1
#endif

__device__ __forceinline__ unsigned xb_ld(unsigned* p)              { return __hip_atomic_load(p, __ATOMIC_RELAXED, __HIP_MEMORY_SCOPE_AGENT); }
__device__ __forceinline__ unsigned xb_add(unsigned* p, unsigned v) { return __hip_atomic_fetch_add(p, v, __ATOMIC_RELAXED, __HIP_MEMORY_SCOPE_AGENT); }
__device__ __forceinline__ unsigned xb_xcc_id() { return (unsigned)__builtin_amdgcn_s_getreg((3 << 11) | 20) & 0xFu; }
#define XB_SPIN(cond, bar) do { unsigned _sp = 0; while (cond) { __builtin_amdgcn_s_sleep(1); \
    if ((++_sp & 255u) == 0u) { if (xb_ld(&(bar)[XB_TMO])) break; if (_sp > XB_SPIN_CAP) { atomicAdd(&(bar)[XB_TMO], 1u); break; } } } } while (0)

struct XcdBarrier {
    unsigned* bar; unsigned x;
    volatile LAS unsigned* st;
};

__device__ __forceinline__ XcdBarrier xcd_barrier_post(unsigned* bar, volatile LAS unsigned* st) {
    XcdBarrier b; b.bar = bar; b.x = xb_xcc_id(); b.st = st;
    if (threadIdx.x == 0) (void)xb_add(&bar[XB_XCNT(b.x)], 1u);
    return b;
}
__device__ __forceinline__ void xcd_barrier_complete(unsigned* bar, unsigned x, unsigned& nloc, unsigned& nx) {
    const unsigned G = gridDim.x * gridDim.y * gridDim.z;
    unsigned sum, cnt, mine, sp = 0u;
    for (;;) {
        sum = 0u; cnt = 0u; mine = 0u;
#pragma unroll
        for (unsigned j = 0; j < 16; ++j) { const unsigned c = xb_ld(&bar[XB_XCNT(j)]); sum += c; cnt += (c > 0u) ? 1u : 0u; mine = (j == x) ? c : mine; }
        if (sum == G) break;
        __builtin_amdgcn_s_sleep(1);
        if ((++sp & 255u) == 0u) { if (xb_ld(&bar[XB_TMO])) break; if (sp > XB_SPIN_CAP) { atomicAdd(&bar[XB_TMO], 1u); break; } }
    }
    nloc = mine > 0u ? mine : 1u; nx = cnt > 0u ? cnt : 1u;
}

__device__ __forceinline__ void xcd_barrier(const XcdBarrier& b) {
    asm volatile("s_waitcnt vmcnt(0)" ::: "memory");
    __syncthreads();
    if (threadIdx.x == 0) {
        unsigned* bar = b.bar;
        __builtin_amdgcn_s_waitcnt(0);
        unsigned nloc = b.st[0], nx = b.st[1];
        if (nloc == 0u) { xcd_barrier_complete(bar, b.x, nloc, nx); b.st[0] = nloc; b.st[1] = nx; }
#if XB_EARLY_WB
        __builtin_amdgcn_fence(__ATOMIC_RELEASE, "agent");
        asm volatile("s_waitcnt vmcnt(0)" ::: "memory");
#endif
        const unsigned old = xb_add(&bar[XB_XSUB(b.x)], 1u);
        const unsigned gen = old / nloc;
        if (old + 1u == (gen + 1u) * nloc) {
#if !XB_EARLY_WB
            __builtin_amdgcn_fence(__ATOMIC_RELEASE, "agent");
#endif
            asm volatile("s_waitcnt vmcnt(0)" ::: "memory");
#if XB_TOPPOLL
            (void)xb_add(&bar[XB_TOP], 1u);
            asm volatile("buffer_inv sc1" ::: "memory");
            XB_SPIN(xb_ld(&bar[XB_TOP]) < (gen + 1u) * nx, bar);
            xb_add(&bar[XB_XGEN(b.x)], 1u);
            asm volatile("s_waitcnt vmcnt(0)" ::: "memory");
        } else if (false) {
#endif
            const unsigned og = xb_add(&bar[XB_TOP], 1u);
            const unsigned tg = og / nx;
#if XB_EARLY_INV
            asm volatile("buffer_inv sc1" ::: "memory");
#endif
            if (og + 1u == (tg + 1u) * nx) xb_add(&bar[XB_TOPGEN], 1u);
            else XB_SPIN(xb_ld(&bar[XB_TOPGEN]) == tg, bar);
#if !XB_EARLY_INV
            __builtin_amdgcn_fence(__ATOMIC_ACQUIRE, "agent");
#endif
#if !XB_FLAT_REL
            xb_add(&bar[XB_XGEN(b.x)], 1u);
#endif
            asm volatile("s_waitcnt vmcnt(0)" ::: "memory");
        } else {
#if XB_EARLY_INV
            asm volatile("buffer_inv sc1" ::: "memory");
#if XB_FLAT_REL
            XB_SPIN(xb_ld(&bar[XB_TOPGEN]) == gen, bar);
#else
            XB_SPIN(xb_ld(&bar[XB_XGEN(b.x)]) == gen, bar);
#endif
#else
            XB_SPIN(xb_ld(&bar[XB_XGEN(b.x)]) == gen, bar);
            __builtin_amdgcn_fence(__ATOMIC_ACQUIRE, "agent");
#endif
            asm volatile("s_waitcnt vmcnt(0)" ::: "memory");
        }
    }
    __syncthreads();
}


__device__ __forceinline__ float shx(float v, int o, int lane) { return __builtin_bit_cast(float, __builtin_amdgcn_ds_bpermute((lane ^ o) << 2, __builtin_bit_cast(int, v))); }
__device__ __forceinline__ int shxi(int v, int o, int lane) { return __builtin_amdgcn_ds_bpermute((lane ^ o) << 2, v); }
__device__ __forceinline__ float wave_sum(float v, int  ) {
#define WS_DPP(ctrl, rmask) __builtin_bit_cast(float, __builtin_amdgcn_update_dpp(0, __builtin_bit_cast(int, v), (ctrl), (rmask), 0xF, false))
    v += WS_DPP(0xB1, 0xF); v += WS_DPP(0x4E, 0xF); v += WS_DPP(0x141, 0xF); v += WS_DPP(0x140, 0xF); v += WS_DPP(0x142, 0xA); v += WS_DPP(0x143, 0xC);
#undef WS_DPP
    return __builtin_bit_cast(float, __builtin_amdgcn_readlane(__builtin_bit_cast(int, v), 63));
}
__device__ __forceinline__ int wave_sum_i(int v, int  ) {
#define WS_DPP(ctrl, rmask) __builtin_amdgcn_update_dpp(0, v, (ctrl), (rmask), 0xF, false)
    v += WS_DPP(0xB1, 0xF); v += WS_DPP(0x4E, 0xF); v += WS_DPP(0x141, 0xF); v += WS_DPP(0x140, 0xF); v += WS_DPP(0x142, 0xA); v += WS_DPP(0x143, 0xC);
#undef WS_DPP
    return __builtin_amdgcn_readlane(v, 63);
}
typedef unsigned u32x2 __attribute__((ext_vector_type(2)));
__device__ __forceinline__ float bf_lo(unsigned w) { return __builtin_bit_cast(float, w << 16); }
__device__ __forceinline__ float bf_hi(unsigned w) { return __builtin_bit_cast(float, w & 0xffff0000u); }
__device__ __forceinline__ u32x2 pack4(const f32x4 v) { u32x2 w; w.x = pg8::cvt_pk_bf16(v[0], v[1]); w.y = pg8::cvt_pk_bf16(v[2], v[3]); return w; }
__device__ __forceinline__ f32x4 unpack4(const u32x2 w) { return (f32x4){bf_lo(w.x), bf_hi(w.x), bf_lo(w.y), bf_hi(w.y)}; }
__device__ __forceinline__ float sum4(const f32x4 v) { return (v[0] + v[1]) + (v[2] + v[3]); }
__device__ __forceinline__ float dot4(const f32x4 a, const f32x4 b) { return (a[0] * b[0] + a[1] * b[1]) + (a[2] * b[2] + a[3] * b[3]); }

template <class Fill> __device__ __forceinline__ void xcd_barrier_fill(const XcdBarrier& b, const Fill& fill) {
    asm volatile("s_waitcnt vmcnt(0)" ::: "memory");
    __syncthreads();
    if (threadIdx.x == 0) {
        unsigned* bar = b.bar;
        __builtin_amdgcn_s_waitcnt(0);
        unsigned nloc = b.st[0], nx = b.st[1];
        if (nloc == 0u) { xcd_barrier_complete(bar, b.x, nloc, nx); b.st[0] = nloc; b.st[1] = nx; }
        const unsigned old = xb_add(&bar[XB_XSUB(b.x)], 1u);
        const unsigned gen = old / nloc;
        if (old + 1u == (gen + 1u) * nloc) {
            __builtin_amdgcn_fence(__ATOMIC_RELEASE, "agent");
            asm volatile("s_waitcnt vmcnt(0)" ::: "memory");
            const unsigned og = xb_add(&bar[XB_TOP], 1u);
            const unsigned tg = og / nx;
            if (og + 1u == (tg + 1u) * nx) xb_add(&bar[XB_TOPGEN], 1u);
            else XB_SPIN(xb_ld(&bar[XB_TOPGEN]) == tg, bar);
            __builtin_amdgcn_fence(__ATOMIC_ACQUIRE, "agent");
            xb_add(&bar[XB_XGEN(b.x)], 1u);
            asm volatile("s_waitcnt vmcnt(0)" ::: "memory");
        } else {
            XB_SPIN(xb_ld(&bar[XB_XGEN(b.x)]) == gen, bar);
            __builtin_amdgcn_fence(__ATOMIC_ACQUIRE, "agent");
            asm volatile("s_waitcnt vmcnt(0)" ::: "memory");
        }
    } else if (threadIdx.x >= 64) fill();
    __syncthreads();
}

struct Ctx {
    LAS unsigned char* lds; unsigned char* ws; int tid, lane, wave, vcu, G, bx;
};
__device__ __forceinline__ Ctx fresh(const Ctx& F0) { Ctx F = F0; int t = threadIdx.x; asm volatile("" : "+v"(t)); F.tid = t; F.lane = t & 63; F.wave = __builtin_amdgcn_readfirstlane(t >> 6); return F; }

struct TItem { const float* src; int ldw; bf16* dst; };
__device__ __forceinline__ void titem_load(f32x4 (&r)[8], const TItem& it, int lane) {
#pragma unroll
    for (int i = 0; i < 8; ++i) r[i] = *(const f32x4*)(it.src + (size_t)(8 * (lane >> 3) + i) * it.ldw + 4 * (lane & 7));
}
__device__ __forceinline__ void titem_finish(const f32x4 (&r)[8], const TItem& it, LAS float* scr, int lane) {
    LAS unsigned char* img = (LAS unsigned char*)scr; const int col4 = lane & 7, krow = lane >> 3;
#pragma unroll
    for (int e = 0; e < 4; ++e) { v4u w; w.x = pg8::cvt_pk_bf16(r[0][e], r[1][e]); w.y = pg8::cvt_pk_bf16(r[2][e], r[3][e]); w.z = pg8::cvt_pk_bf16(r[4][e], r[5][e]); w.w = pg8::cvt_pk_bf16(r[6][e], r[7][e]);
        *(LAS v4u*)(img + (4 * col4 + e) * 128 + ((krow ^ col4) << 4)) = w; }
    LDS_WAIT(); asm volatile("" ::: "memory");
    const int c = lane & 7;
#pragma unroll
    for (int j = 0; j < 4; ++j) { const int n = (lane >> 3) + 8 * j; const v4u o = *(const LAS v4u*)(img + n * 128 + ((c ^ ((n >> 2) & 7)) << 4));
        *(GAS v4u*)(it.dst + (size_t)n * 1024 + 8 * c) = o; }
    LDS_WAIT(); asm volatile("" ::: "memory");
}
__device__ __forceinline__ int win_src_col(int g) { const int pn = g >> 3, bj = (g >> 2) & 1, wc = g & 3;
    if (pn < 2) return 64 * (4 * pn + wc) + 32 * bj;
    if (pn == 2) return (wc < 2 ? 512 + 64 * wc : 640 + 64 * (wc - 2)) + 32 * bj;
    return (bj == 0 ? 768 : 1280) + 128 * (pn - 3) + 32 * wc; }
__device__ __forceinline__ int scin_src_col(int g) { const int pn = g >> 3, bj = (g >> 2) & 1, wc = g & 3;
    if (pn < 4) return 32 * g;
    return (bj == 0 ? 1024 : 2048) + 128 * (pn - 4) + 32 * wc; }

constexpr int I_WIN = 16 * 56, I_WOUT = 16 * 32, I_SCIN = 16 * 96, I_SCOUT = 16 * 32, I_SMALL = I_WIN + I_WOUT + I_SCIN + I_SCOUT, I_MOE = 32 * 1536, NITEMS = I_SMALL + I_MOE;
#ifndef MK_BARFILL
#define MK_BARFILL 0
#endif
constexpr int BF_SEAM0 = 3, BF_NSEAM = MK_BARFILL ? 10 : 0, BF_ITEMS = BF_NSEAM * 256 * 7;
#ifndef MK_P0_WIN_ONLY
#define MK_P0_WIN_ONLY 0
#endif
constexpr int I_POOL0 = MK_P0_WIN_ONLY ? I_WIN : I_SMALL;
#ifndef MK_TKN
#define MK_TKN 0
#endif
constexpr int TK_PER = 192 * NWAVES * MK_TKN, TK_ITEMS = 2 * TK_PER;
constexpr int CHUNK_ITEMS = 64, NCHUNK = (NITEMS - I_POOL0 - BF_ITEMS - TK_ITEMS) / CHUNK_ITEMS;
static_assert(BF_ITEMS == 0 || TK_ITEMS == 0, "one kind of filler");
static_assert((I_MOE - BF_ITEMS - TK_ITEMS) % CHUNK_ITEMS == 0 && I_MOE - BF_ITEMS - TK_ITEMS > I_MOE / 2, "barrier-filler items all belong to layer 1");
static_assert(I_MOE % CHUNK_ITEMS == 0 && (NITEMS - I_POOL0) % CHUNK_ITEMS == 0, "chunks");
template <class AP> __device__ __forceinline__ TItem decode_item(const Ctx& F, AP ap, int it) {
#define in ap->in
    int r = it;
    if (r < I_WIN) { const int kb = r / 56, g = r % 56; return TItem{in[8] + (size_t)kb * 64 * EIN + win_src_col(g), EIN, (bf16*)(F.ws + WS_WIN) + (size_t)g * 32 * 1024 + kb * 64}; } r -= I_WIN;
    if (r < I_WOUT) { const int kb = r / 32, g = r % 32; return TItem{in[15] + (size_t)kb * 64 * 1024 + g * 32, 1024, (bf16*)(F.ws + WS_WOUT) + (size_t)g * 32 * 1024 + kb * 64}; } r -= I_WOUT;
    if (r < I_SCIN) { const int kb = r / 96, g = r % 96; return TItem{in[16] + (size_t)kb * 64 * 3072 + scin_src_col(g), 3072, (bf16*)(F.ws + WS_SCIN) + (size_t)g * 32 * 1024 + kb * 64}; } r -= I_SCIN;
    if (r < I_SCOUT) { const int kb = r / 32, g = r % 32; return TItem{in[18] + (size_t)kb * 64 * 1024 + g * 32, 1024, (bf16*)(F.ws + WS_SCOUT) + (size_t)g * 32 * 1024 + kb * 64}; } r -= I_SCOUT;
    const int le = r / 1536, q = r % 1536, which = q >> 9, q2 = q & 511;
#if MK_CVMAP == 1
    const int kb = ((q2 >> 6) & 1) * 8 + (q2 & 7), g = (q2 >> 7) * 8 + ((q2 >> 3) & 7);
#elif MK_CVMAP == 2
    const int kb = q2 & 15, g = q2 >> 4;
#else
    const int kb = q2 >> 5, g = q2 & 31;
#endif
    const size_t so = (size_t)le * 1024 * 1024 + (size_t)kb * 64 * 1024 + g * 32;
    if (which == 2) return TItem{in[22] + so, 1024, (bf16*)(F.ws + WS_DN) + (size_t)le * 1024 * 1024 + (size_t)g * 32 * 1024 + kb * 64};
    const int pos = 256 * (g >> 2) + 128 * which + 32 * (g & 3);
    return TItem{(which == 0 ? in[20] : in[21]) + so, 1024, (bf16*)(F.ws + WS_GU) + (size_t)le * 2048 * 1024 + (size_t)pos * 1024 + kb * 64};
#undef in
}
template <class AP> __device__ __forceinline__ void convert_items(const Ctx& F, AP ap, int first, int end, int stride) {
    LAS float* scr = (LAS float*)(F.lds + RING_OFF + F.wave * 16384);
    f32x4 ra[8], rb[8]; TItem A, B;
    int it = first;
    if (it < end) { A = decode_item(F, ap, it); titem_load(ra, A, F.lane); }
    while (it < end) {
        int nx = it + stride;
        if (nx < end) { B = decode_item(F, ap, nx); titem_load(rb, B, F.lane); }
        titem_finish(ra, A, scr, F.lane);
        it = nx; if (it >= end) break;
        nx = it + stride;
        if (nx < end) { A = decode_item(F, ap, nx); titem_load(ra, A, F.lane); }
        titem_finish(rb, B, scr, F.lane);
        it = nx;
    }
}

template <class AP> __device__ __forceinline__ void convert_items8(const Ctx& F, AP ap, int first) {
    LAS float* scr = (LAS float*)(F.lds + RING_OFF + F.wave * 16384);
    f32x4 r0[8], r1[8], r2[8]; TItem a0, a1, a2;
#define CI_LOAD(r, it, k) do { it = decode_item(F, ap, first + (k)); titem_load(r, it, F.lane); } while (0)
    CI_LOAD(r0, a0, 0); CI_LOAD(r1, a1, 1); CI_LOAD(r2, a2, 2);
    titem_finish(r0, a0, scr, F.lane); CI_LOAD(r0, a0, 3);
    titem_finish(r1, a1, scr, F.lane); CI_LOAD(r1, a1, 4);
    titem_finish(r2, a2, scr, F.lane); CI_LOAD(r2, a2, 5);
    titem_finish(r0, a0, scr, F.lane); CI_LOAD(r0, a0, 6);
    titem_finish(r1, a1, scr, F.lane); CI_LOAD(r1, a1, 7);
    titem_finish(r2, a2, scr, F.lane); titem_finish(r0, a0, scr, F.lane); titem_finish(r1, a1, scr, F.lane);
#undef CI_LOAD
}

#ifndef MK_CVD
#define MK_CVD 5
#endif
template <class AP> __device__ __forceinline__ void convert_items8d(const Ctx& F, AP ap, int first) {
    LAS float* scr = (LAS float*)(F.lds + RING_OFF + F.wave * 16384);
    f32x4 r0[8], r1[8], r2[8], r3[8]; TItem a0, a1, a2, a3;
#define CI_LOAD(r, it, k) do { it = decode_item(F, ap, first + (k)); titem_load(r, it, F.lane); } while (0)
#define CI_FIN(r, it) titem_finish(r, it, scr, F.lane)
#if MK_CVD == 4
    CI_LOAD(r0, a0, 0); CI_LOAD(r1, a1, 1); CI_LOAD(r2, a2, 2); CI_LOAD(r3, a3, 3);
    CI_FIN(r0, a0); CI_LOAD(r0, a0, 4); CI_FIN(r1, a1); CI_LOAD(r1, a1, 5); CI_FIN(r2, a2); CI_LOAD(r2, a2, 6); CI_FIN(r3, a3); CI_LOAD(r3, a3, 7);
    CI_FIN(r0, a0); CI_FIN(r1, a1); CI_FIN(r2, a2); CI_FIN(r3, a3);
#elif MK_CVD == 5
    f32x4 r4[8]; TItem a4;
    CI_LOAD(r0, a0, 0); CI_LOAD(r1, a1, 1); CI_LOAD(r2, a2, 2); CI_LOAD(r3, a3, 3); CI_LOAD(r4, a4, 4);
    CI_FIN(r0, a0); CI_LOAD(r0, a0, 5); CI_FIN(r1, a1); CI_LOAD(r1, a1, 6); CI_FIN(r2, a2); CI_LOAD(r2, a2, 7);
    CI_FIN(r3, a3); CI_FIN(r4, a4); CI_FIN(r0, a0); CI_FIN(r1, a1); CI_FIN(r2, a2);
#else
    f32x4 r4[8], r5[8]; TItem a4, a5;
    CI_LOAD(r0, a0, 0); CI_LOAD(r1, a1, 1); CI_LOAD(r2, a2, 2); CI_LOAD(r3, a3, 3); CI_LOAD(r4, a4, 4); CI_LOAD(r5, a5, 5);
    CI_FIN(r0, a0); CI_LOAD(r0, a0, 6); CI_FIN(r1, a1); CI_LOAD(r1, a1, 7);
    CI_FIN(r2, a2); CI_FIN(r3, a3); CI_FIN(r4, a4); CI_FIN(r5, a5); CI_FIN(r0, a0); CI_FIN(r1, a1);
#endif
#undef CI_LOAD
#undef CI_FIN
}

template <class AP> __device__ __forceinline__ void convert_item1(const Ctx& F, AP ap, int item) {
    LAS float* scr = (LAS float*)(F.lds + RING_OFF + F.wave * 16384);
    f32x4 r0[8]; const TItem a0 = decode_item(F, ap, item); titem_load(r0, a0, F.lane); titem_finish(r0, a0, scr, F.lane);
}

template <class AP> __device__ __forceinline__ void phase0(const Ctx& F0, AP ap) {
    const Ctx F = fresh(F0);
#define in ap->in
    float* Mod = (float*)(F.ws + WS_MOD);
    if (F.bx < 192) {
        LAS float* sv = (LAS float*)F.lds; LAS float* part = sv + 5 * 1024;
        for (int i = F.tid; i < 5 * 1024; i += NWAVES * 64) { const int v = i >> 10, k = i & 1023; const float x = v < 4 ? in[1][v * 1024 + k] : in[3][k]; sv[i] = x / (1.f + __expf(-x)); }
        __syncthreads();
        const int l = F.bx / 96, n0 = (F.bx % 96) * 64, k0 = F.wave * 128;
        const float* w = in[4] + (size_t)l * 1024 * NMOD6 + n0 + F.lane;
        float a[5] = {0.f, 0.f, 0.f, 0.f, 0.f};
#pragma unroll 32
        for (int k = 0; k < 128; ++k) { const float wv = w[(size_t)(k0 + k) * NMOD6];
#pragma unroll
            for (int v = 0; v < 5; ++v) a[v] += sv[v * 1024 + k0 + k] * wv; }
#pragma unroll
        for (int v = 0; v < 5; ++v) part[(F.wave * 5 + v) * 64 + F.lane] = a[v];
        __syncthreads();
        if (F.tid < 320) { const int v = F.tid >> 6, ln = F.tid & 63; float s = 0.f;
#pragma unroll
            for (int ww = 0; ww < 8; ++ww) s += part[(ww * 5 + v) * 64 + ln];
            Mod[(size_t)(l * 5 + v) * NMOD6 + n0 + ln] = s + in[5][l * NMOD6 + n0 + ln]; }
        __syncthreads();
    }
    { const int idx = F.bx * (NWAVES * 64) + F.tid;
      if (idx < SEQ * 32) { const int t = idx >> 5, d = idx & 31; const float pos = d < 16 ? (float)(t >> 6) : (float)(t & 63);
          const float inv = exp2f(-(float)(2 * (d & 15)) * (13.287712379549449f / 32.f)); const float ang = pos * inv;
          ((float*)(F.ws + WS_ROPE))[idx] = cosf(ang); ((float*)(F.ws + WS_ROPE))[SEQ * 32 + idx] = sinf(ang); } }
#undef in
#if MK_P0_WIN_ONLY
    if (F.bx >= 192) convert_items(F, ap, (F.bx - 192) * NWAVES + F.wave, I_WIN, (F.G - 192) * NWAVES);
#elif MK_P0_BAL
    static_assert(4 * 64 * NWAVES + 192 * NWAVES >= I_SMALL, "phase-0 item shares");
    if (F.bx >= 192) convert_items(F, ap, (F.bx - 192) * NWAVES + F.wave, 4 * 64 * NWAVES, 64 * NWAVES);
    else convert_items(F, ap, 4 * 64 * NWAVES + F.bx * NWAVES + F.wave, I_SMALL, 1 << 20);
#else
    convert_items(F, ap, F.vcu * NWAVES + F.wave, I_SMALL, F.G * NWAVES);
#endif
}

struct Row16 { f32x4 a[2][2]; };
__device__ __forceinline__ void ld_f32(Row16& r, const float* row, int lane) {
#pragma unroll
    for (int jj = 0; jj < 2; ++jj) { r.a[jj][0] = ((const f32x4*)row)[2 * (lane + 64 * jj)]; r.a[jj][1] = ((const f32x4*)row)[2 * (lane + 64 * jj) + 1]; } }
__device__ __forceinline__ void un_bf16(Row16& r, const v4u (&w)[2]) {
#pragma unroll
    for (int jj = 0; jj < 2; ++jj) { r.a[jj][0] = (f32x4){bf_lo(w[jj][0]), bf_hi(w[jj][0]), bf_lo(w[jj][1]), bf_hi(w[jj][1])}; r.a[jj][1] = (f32x4){bf_lo(w[jj][2]), bf_hi(w[jj][2]), bf_lo(w[jj][3]), bf_hi(w[jj][3])}; } }
__device__ __forceinline__ void st_bf16(bf16* row, int lane, const Row16& r) {
#pragma unroll
    for (int jj = 0; jj < 2; ++jj) ((v4u*)row)[lane + 64 * jj] = pg8::pack8(r.a[jj][0], r.a[jj][1]); }
__device__ __forceinline__ float sumsq(const Row16& r) { return (dot4(r.a[0][0], r.a[0][0]) + dot4(r.a[0][1], r.a[0][1])) + (dot4(r.a[1][0], r.a[1][0]) + dot4(r.a[1][1], r.a[1][1])); }

__device__ __forceinline__ void phase_norm1(const Ctx& F0, const float* src, const float* ctxsrc, const float* g1, const float* modl) {
    const Ctx F = fresh(F0);
    bf16* XN = (bf16*)(F.ws + WS_XN);
    const int gw = F.vcu * NWAVES + F.wave, NGW = F.G * NWAVES;
    int cr = F.wave < 4 ? F.vcu * 4 + F.wave : NB * CTXL;
    for (int grp = gw; grp < 2048 || cr < NB * CTXL; grp += NGW) {
        const bool dm = grp < 2048, dc = cr < NB * CTXL; const int row0 = dm ? grp * 8 : 0;
        const float* sp = src + (size_t)row0 * DM; bf16* dp = XN + (size_t)row0 * DM;
        const float* mm = modl + (size_t)(row0 >> 12) * NMOD6;
        Row16 v[8], vc;
        if (dm) {
#pragma unroll
            for (int r = 0; r < 8; ++r) ld_f32(v[r], sp + (size_t)r * DM, F.lane); }
        if (dc) ld_f32(vc, ctxsrc + (size_t)cr * DM, F.lane);
        Row16 gs, sh, tmp; ld_f32(gs, g1, F.lane); ld_f32(tmp, mm + 1024, F.lane); ld_f32(sh, mm, F.lane);
        asm volatile("" ::: "memory");
        Row16 g0 = gs;
#pragma unroll
        for (int jj = 0; jj < 2; ++jj)
#pragma unroll
            for (int hf = 0; hf < 2; ++hf) gs.a[jj][hf] = gs.a[jj][hf] * (tmp.a[jj][hf] + 1.0f);
        if (dm) {
            float ss[8];
#pragma unroll
            for (int r = 0; r < 8; ++r) ss[r] = sumsq(v[r]);
#pragma unroll
            for (int r = 0; r < 8; ++r) ss[r] = wave_sum(ss[r], F.lane);
#pragma unroll
            for (int r = 0; r < 8; ++r) { const float rstd = __builtin_amdgcn_rsqf(ss[r] * (1.f / DM) + EPSN); Row16 o;
#pragma unroll
                for (int jj = 0; jj < 2; ++jj)
#pragma unroll
                    for (int hf = 0; hf < 2; ++hf) o.a[jj][hf] = v[r].a[jj][hf] * rstd * gs.a[jj][hf] + sh.a[jj][hf];
                st_bf16(dp + (size_t)r * DM, F.lane, o); } }
        if (dc) {
            const float* mc = modl + (size_t)4 * NMOD6; ld_f32(tmp, mc + 1024, F.lane); ld_f32(sh, mc, F.lane);
            const float rstd = __builtin_amdgcn_rsqf(wave_sum(sumsq(vc), F.lane) * (1.f / DM) + EPSN); Row16 o;
#pragma unroll
            for (int jj = 0; jj < 2; ++jj)
#pragma unroll
                for (int hf = 0; hf < 2; ++hf) o.a[jj][hf] = vc.a[jj][hf] * rstd * (g0.a[jj][hf] * (tmp.a[jj][hf] + 1.0f)) + sh.a[jj][hf];
            st_bf16(XN + (size_t)(MTOK + cr) * DM, F.lane, o);
            cr += F.G * 4; }
    }
}

__device__ __forceinline__ float row16_max(float v) {
#define R16(ctrl) __builtin_bit_cast(float, __builtin_amdgcn_update_dpp(__builtin_bit_cast(int, v), __builtin_bit_cast(int, v), (ctrl), 0xF, 0xF, false))
    v = fmaxf(v, R16(0xB1)); v = fmaxf(v, R16(0x4E)); v = fmaxf(v, R16(0x141)); v = fmaxf(v, R16(0x140)); return v;
#undef R16
}
__device__ __forceinline__ float row16_sum(float v) {
#define R16(ctrl) __builtin_bit_cast(float, __builtin_amdgcn_update_dpp(0, __builtin_bit_cast(int, v), (ctrl), 0xF, 0xF, false))
    v += R16(0xB1); v += R16(0x4E); v += R16(0x141); v += R16(0x140); return v;
#undef R16
}
constexpr size_t BSET_OFF = 262144, BSET_STRIDE = 65536 + 512;
__device__ __forceinline__ void build_bset(const Ctx& F0, const float* g2, const float* mm, const float* wr, int idx) {
    const Ctx F = fresh(F0);
    v4u* BH = (v4u*)(F.ws + WS_CTL + BSET_OFF + (size_t)idx * BSET_STRIDE); v4u* BL = BH + 2048; float* biasg = (float*)(BL + 2048);
    LAS float* pbl = (LAS float*)(F.lds + 65536);
    __syncthreads();
    { const int e = F.tid & 15, kq = (F.tid & 63) >> 4; float pb = 0.f;
#pragma unroll
      for (int q = 0; q < 4; ++q) { const int fid = F.tid + 512 * q, s = fid >> 6, c0 = 32 * s + 8 * kq; float wv[8], lo[8]; unsigned hb[8];
#pragma unroll
          for (int j = 0; j < 8; ++j) { const int c = c0 + j; const float w = wr[(size_t)c * NE + e]; wv[j] = g2[c] * (mm[4 * 1024 + c] + 1.0f) * w; pb += mm[3 * 1024 + c] * w;
              hb[j] = f2bf(wv[j]); lo[j] = wv[j] - __builtin_bit_cast(float, hb[j] << 16); }
          BH[fid] = (v4u){hb[0] | (hb[1] << 16), hb[2] | (hb[3] << 16), hb[4] | (hb[5] << 16), hb[6] | (hb[7] << 16)};
          BL[fid] = (v4u){pk2(lo[0], lo[1]), pk2(lo[2], lo[3]), pk2(lo[4], lo[5]), pk2(lo[6], lo[7])}; }
      pbl[F.tid] = pb; }
    __syncthreads();
    if (F.tid < 16) { float s = 0.f;
#pragma unroll
        for (int w = 0; w < 8; ++w)
#pragma unroll
            for (int k4 = 0; k4 < 4; ++k4) s += pbl[w * 64 + k4 * 16 + F.tid];
        biasg[F.tid] = s; }
    __syncthreads();
}
__device__ __forceinline__ void phase_norm2_router(const Ctx& F0, const float* g2, const float* modl, const float* wr, int layer) {
    const Ctx F = fresh(F0);
    const bf16* Hb = (const bf16*)(F.ws + WS_H); bf16* XN = (bf16*)(F.ws + WS_XN); float* AFF = (float*)(F.ws + WS_AFF);
    LAS v4u* BH = (LAS v4u*)F.lds; LAS v4u* BL = BH + 2048; LAS float* pbl = (LAS float*)(F.lds + 65536); LAS float* biasl = pbl + 512;
    for (int blk = F.vcu; blk < MTOK / 64; blk += F.G) {
        const int rowb = blk * 64, row0 = rowb + F.wave * 8; const float* mm = modl + (size_t)(rowb >> 12) * NMOD6;
#if MK_N2_ALL8
        v4u cur[8][2];
#pragma unroll
        for (int rr = 0; rr < 8; ++rr)
#pragma unroll
            for (int jj = 0; jj < 2; ++jj) cur[rr][jj] = ((const v4u*)(Hb + (size_t)(row0 + rr) * DM))[F.lane + 64 * jj];
        asm volatile("" ::: "memory");
#else
        v4u cur[2][2], nxt[2][2];
#pragma unroll
        for (int rr = 0; rr < 2; ++rr)
#pragma unroll
            for (int jj = 0; jj < 2; ++jj) cur[rr][jj] = ((const v4u*)(Hb + (size_t)(row0 + rr) * DM))[F.lane + 64 * jj];
#endif
        __syncthreads();
#if MK_BSET
        { const v4u* BHg = (const v4u*)(F.ws + WS_CTL + BSET_OFF + (size_t)(layer * 4 + (rowb >> 12)) * BSET_STRIDE);
          v4u tq[8];
#pragma unroll
          for (int q = 0; q < 8; ++q) tq[q] = BHg[F.tid + 512 * q];
          const float bq = F.tid < 16 ? ((const float*)(BHg + 4096))[F.tid] : 0.f;
#pragma unroll
          for (int q = 0; q < 8; ++q) BH[F.tid + 512 * q] = tq[q];
          if (F.tid < 16) biasl[F.tid] = bq; }
#else
        { const int e = F.tid & 15, kq = (F.tid & 63) >> 4; float pb = 0.f;
#pragma unroll
          for (int q = 0; q < 4; ++q) { const int fid = F.tid + 512 * q, s = fid >> 6, c0 = 32 * s + 8 * kq; float wv[8], lo[8]; unsigned hb[8];
#pragma unroll
              for (int j = 0; j < 8; ++j) { const int c = c0 + j; const float w = wr[(size_t)c * NE + e]; wv[j] = g2[c] * (mm[4 * 1024 + c] + 1.0f) * w; pb += mm[3 * 1024 + c] * w;
                  hb[j] = f2bf(wv[j]); lo[j] = wv[j] - __builtin_bit_cast(float, hb[j] << 16); }
              BH[fid] = (v4u){hb[0] | (hb[1] << 16), hb[2] | (hb[3] << 16), hb[4] | (hb[5] << 16), hb[6] | (hb[7] << 16)};
              BL[fid] = (v4u){pk2(lo[0], lo[1]), pk2(lo[2], lo[3]), pk2(lo[4], lo[5]), pk2(lo[6], lo[7])}; }
          pbl[F.tid] = pb; }
#endif
        Row16 gs, sh;
        { Row16 tmp; ld_f32(gs, g2, F.lane); ld_f32(tmp, mm + 4 * 1024, F.lane); ld_f32(sh, mm + 3 * 1024, F.lane);
#pragma unroll
          for (int jj = 0; jj < 2; ++jj)
#pragma unroll
            for (int hf = 0; hf < 2; ++hf) gs.a[jj][hf] = gs.a[jj][hf] * (tmp.a[jj][hf] + 1.0f); }
        __syncthreads();
        TP_STAMP(F, 1);
#if !MK_BSET
        if (F.tid < 16) { float s = 0.f;
#pragma unroll
            for (int w = 0; w < 8; ++w)
#pragma unroll
                for (int k4 = 0; k4 < 4; ++k4) s += pbl[w * 64 + k4 * 16 + F.tid];
            biasl[F.tid] = s; }
#endif
        float rstd[8];
#pragma unroll
        for (int rp = 0; rp < 4; ++rp) {
#if !MK_N2_ALL8
            if (rp < 3) {
#pragma unroll
                for (int rr = 0; rr < 2; ++rr)
#pragma unroll
                    for (int jj = 0; jj < 2; ++jj) nxt[rr][jj] = ((const v4u*)(Hb + (size_t)(row0 + 2 * rp + 2 + rr) * DM))[F.lane + 64 * jj]; }
#endif
#pragma unroll
            for (int rr = 0; rr < 2; ++rr) { Row16 x; un_bf16(x, cur[MK_N2_ALL8 ? 2 * rp + rr : rr]);
                rstd[2 * rp + rr] = __builtin_amdgcn_rsqf(wave_sum(sumsq(x), F.lane) * (1.f / DM) + EPSN);
#if !MK_N2_LATE
                Row16 o;
#pragma unroll
                for (int jj = 0; jj < 2; ++jj)
#pragma unroll
                    for (int hf = 0; hf < 2; ++hf) o.a[jj][hf] = x.a[jj][hf] * rstd[2 * rp + rr] * gs.a[jj][hf] + sh.a[jj][hf];
                st_bf16(XN + (size_t)(row0 + 2 * rp + rr) * DM, F.lane, o);
#endif
            }
#if !MK_N2_ALL8
#pragma unroll
            for (int rr = 0; rr < 2; ++rr)
#pragma unroll
                for (int jj = 0; jj < 2; ++jj) cur[rr][jj] = nxt[rr][jj];
#endif
        }
        __syncthreads();
        TP_STAMP(F, 2);
        { const int r = F.lane & 7, kq = F.lane >> 4; const bf16* ap = Hb + (size_t)(row0 + r) * DM + 8 * kq;
          pg8::f32x4 acc = (pg8::f32x4){0.f, 0.f, 0.f, 0.f};
#if MK_N2_AF32
#pragma unroll
          for (int sg = 0; sg < 2; ++sg) { pg8::bf16x8 af[16];
#pragma unroll
              for (int k = 0; k < 16; ++k) af[k] = *(const pg8::bf16x8*)(ap + 32 * (16 * sg + k));
              asm volatile("" ::: "memory");
#pragma unroll
              for (int k = 0; k < 16; ++k) { const int s = 16 * sg + k; const pg8::bf16x8 bh = __builtin_bit_cast(pg8::bf16x8, BH[s * 64 + F.lane]), bl = __builtin_bit_cast(pg8::bf16x8, BL[s * 64 + F.lane]);
                  acc = __builtin_amdgcn_mfma_f32_16x16x32_bf16(af[k], bh, acc, 0, 0, 0); acc = __builtin_amdgcn_mfma_f32_16x16x32_bf16(af[k], bl, acc, 0, 0, 0); } }
#else
#pragma unroll
          for (int sg = 0; sg < 4; ++sg) { pg8::bf16x8 af[8];
#pragma unroll
              for (int k = 0; k < 8; ++k) af[k] = *(const pg8::bf16x8*)(ap + 32 * (8 * sg + k));
#pragma unroll
              for (int k = 0; k < 8; ++k) { const int s = 8 * sg + k; const pg8::bf16x8 bh = __builtin_bit_cast(pg8::bf16x8, BH[s * 64 + F.lane]), bl = __builtin_bit_cast(pg8::bf16x8, BL[s * 64 + F.lane]);
                  acc = __builtin_amdgcn_mfma_f32_16x16x32_bf16(af[k], bh, acc, 0, 0, 0); acc = __builtin_amdgcn_mfma_f32_16x16x32_bf16(af[k], bl, acc, 0, 0, 0); } }
#endif
          TP_STAMP(F, 3);
          const float be = biasl[F.lane & 15]; const bool lowq = kq == 0;
#pragma unroll
          for (int reg = 0; reg < 4; ++reg) { const float rs = lowq ? rstd[reg] : rstd[4 + reg]; const float lg = acc[reg] * rs + be;
              const float mx = row16_max(lg), p = __expf(lg - mx), s = row16_sum(p);
#if MK_TKT
              if (kq < 2) { const int row = row0 + 4 * kq + reg; AFF[((size_t)((row >> 12) * NE + (F.lane & 15))) * SEQ + (row & (SEQ - 1))] = p / s; } } }
#else
              if (kq < 2) AFF[(size_t)(row0 + 4 * kq + reg) * NE + (F.lane & 15)] = p / s; } }
#endif
#if MK_N2_LATE
#pragma unroll
        for (int rr = 0; rr < 8; ++rr)
#pragma unroll
            for (int jj = 0; jj < 2; ++jj) cur[rr][jj] = ((const v4u*)(Hb + (size_t)(row0 + rr) * DM))[F.lane + 64 * jj];
        asm volatile("" ::: "memory");
#pragma unroll
        for (int r8 = 0; r8 < 8; ++r8) { Row16 x, o; un_bf16(x, cur[r8]);
#pragma unroll
            for (int jj = 0; jj < 2; ++jj)
#pragma unroll
                for (int hf = 0; hf < 2; ++hf) o.a[jj][hf] = x.a[jj][hf] * rstd[r8] * gs.a[jj][hf] + sh.a[jj][hf];
            st_bf16(XN + (size_t)(row0 + r8) * DM, F.lane, o); }
#endif
        __syncthreads();
    }
}

__device__ __forceinline__ int block_excl_scan(const Ctx& F, int x, LAS int* scr, int& total) {
    int inc = x;
#pragma unroll
    for (int o = 1; o < 64; o <<= 1) { const int y = __builtin_amdgcn_ds_bpermute(((F.lane - o) & 63) << 2, inc); if (F.lane >= o) inc += y; }
    __syncthreads();
    if (F.lane == 63) scr[F.wave] = inc;
    __syncthreads();
    int base = 0, tot = 0;
#pragma unroll
    for (int w = 0; w < 8; ++w) { const int c = scr[w]; if (w < F.wave) base += c; tot += c; }
    total = tot; return base + inc - x;
}
template <class AP> __device__ __forceinline__ void phase_topk(const Ctx& F0, AP ap, int l) {
    const Ctx F = fresh(F0);
    if (F.bx >= NB * NE) {
#if MK_TKN > 0
        if (F.bx < NB * NE + 192) { const int first = NITEMS - TK_ITEMS + l * TK_PER + ((F.bx - NB * NE) * NWAVES + F.wave) * MK_TKN;
            LAS float* scr = (LAS float*)(F.lds + RING_OFF + F.wave * 16384);
            f32x4 r0[8], r1[8], r2[8]; TItem a0, a1, a2;
            a0 = decode_item(F, ap, first); titem_load(r0, a0, F.lane);
            if (MK_TKN > 1) { a1 = decode_item(F, ap, first + 1); titem_load(r1, a1, F.lane); }
            if (MK_TKN > 2) { a2 = decode_item(F, ap, first + 2); titem_load(r2, a2, F.lane); }
            titem_finish(r0, a0, scr, F.lane);
            if (MK_TKN > 3) { a0 = decode_item(F, ap, first + 3); titem_load(r0, a0, F.lane); }
            if (MK_TKN > 1) titem_finish(r1, a1, scr, F.lane);
            if (MK_TKN > 2) titem_finish(r2, a2, scr, F.lane);
            if (MK_TKN > 3) titem_finish(r0, a0, scr, F.lane); }
#endif
        return; }
    const float* AFF = (const float*)(F.ws + WS_AFF); float* GV = (float*)(F.ws + WS_GV); unsigned* GOFF = (unsigned*)(F.ws + WS_GOFF); int* INV = (int*)(F.ws + WS_INV);
    const int b = F.bx >> 4, e = F.bx & 15;
    LAS int* cnt = (LAS int*)F.lds;
    unsigned v[8];
#pragma unroll
#if MK_TKT
    for (int k = 0; k < 8; ++k) v[k] = __builtin_bit_cast(unsigned, AFF[((size_t)(b * NE + e)) * SEQ + F.tid * 8 + k]);
#else
    for (int k = 0; k < 8; ++k) v[k] = __builtin_bit_cast(unsigned, AFF[((size_t)b * SEQ + F.tid * 8 + k) * NE + e]);
#endif
    LAS unsigned* hist = (LAS unsigned*)F.lds + 64;
    LAS unsigned* pick = hist + 256;
    unsigned T = 0u; int krem = CAP;
#pragma unroll 1
    for (int pass = 0; pass < 4; ++pass) {
        const int shift = 24 - 8 * pass;
        if (F.tid < 256) hist[F.tid] = 0u;
        __syncthreads();
#pragma unroll
        for (int k = 0; k < 8; ++k) if (pass == 0 || (v[k] >> (shift + 8)) == T) __hip_atomic_fetch_add(hist + ((v[k] >> shift) & 255u), 1u, __ATOMIC_RELAXED, __HIP_MEMORY_SCOPE_WORKGROUP);
        __syncthreads();
        if (F.wave == 0) {
            const int c0 = (int)hist[4 * F.lane], c1 = (int)hist[4 * F.lane + 1], c2 = (int)hist[4 * F.lane + 2], c3 = (int)hist[4 * F.lane + 3];
            const int s = c0 + c1 + c2 + c3; int t = s;
#pragma unroll
            for (int o = 1; o < 64; o <<= 1) { const int y = __builtin_amdgcn_ds_bpermute(((F.lane + o) & 63) << 2, t); if (F.lane + o < 64) t += y; }
            const int excl = t - s;
            if (excl < krem && krem <= t) { int r = krem - excl, d;
                if (r <= c3) d = 3; else { r -= c3; if (r <= c2) d = 2; else { r -= c2; if (r <= c1) d = 1; else { r -= c1; d = 0; } } }
                pick[0] = (unsigned)(4 * F.lane + d); pick[1] = (unsigned)r; }
        }
        __syncthreads();
        T = (T << 8) | pick[0]; krem = (int)pick[1];
    }
    int tc = 0, gc = 0;
#pragma unroll
    for (int k = 0; k < 8; ++k) { tc += (v[k] == T) ? 1 : 0; gc += (v[k] > T) ? 1 : 0; }
    int ttot, stot;
    const int tp = block_excl_scan(F, tc, cnt + 32, ttot);
    const int need = krem;
    int tsel = need - tp; tsel = tsel < 0 ? 0 : (tsel > tc ? tc : tsel);
    int slot = block_excl_scan(F, gc + tsel, cnt + 32, stot);
    int tpr = tp;
#if MK_TKT
    int inv8[8];
#endif
#pragma unroll
    for (int k = 0; k < 8; ++k) { const int t = F.tid * 8 + k; const bool tie = v[k] == T; const bool sel = v[k] > T || (tie && tpr < need); if (tie) ++tpr;
        const size_t tokrow = (size_t)b * SEQ + t;
#if MK_TKT
        int iv = -1;
        if (sel) { const size_t R = (size_t)(e * NB + b) * CAP + slot; GOFF[R] = (unsigned)(tokrow * (DM * 2)); GV[R] = __builtin_bit_cast(float, v[k]); iv = slot; ++slot; }
        inv8[k] = iv; }
    { int* ip = INV + ((size_t)(b * NE + e)) * SEQ + F.tid * 8;
      typedef int i32x4 __attribute__((ext_vector_type(4)));
      ((i32x4*)ip)[0] = (i32x4){inv8[0], inv8[1], inv8[2], inv8[3]}; ((i32x4*)ip)[1] = (i32x4){inv8[4], inv8[5], inv8[6], inv8[7]}; }
#else
        if (sel) { const size_t R = (size_t)(e * NB + b) * CAP + slot; GOFF[R] = (unsigned)(tokrow * (DM * 2)); GV[R] = __builtin_bit_cast(float, v[k]); INV[tokrow * NE + e] = slot; ++slot; }
        else INV[tokrow * NE + e] = -1; }
#endif
}

template <bool FINAL>
__device__ __forceinline__ void phase_combine(const Ctx& F0, const float* modl, const float* gnext, const float* modnext, float* out) {
    const Ctx F = fresh(F0);
    bf16* Hb = (bf16*)(F.ws + WS_H); bf16* XN = (bf16*)(F.ws + WS_XN); const bf16* Y = (const bf16*)(F.ws + WS_RA + RA_Y);
    const float* GV = (const float*)(F.ws + WS_GV); const int* INV = (const int*)(F.ws + WS_INV);
    const int gw = F.vcu * NWAVES + F.wave, NGW = F.G * NWAVES;
    for (int grp = gw; grp < 2048; grp += NGW) {
        const int row0 = grp * 8, b = row0 >> 12; const float* mm = modl + (size_t)b * NMOD6;
        int sl0, sl1; float gv0, gv1;
        { const int e = F.lane & 15, rr = F.lane >> 4;
#if MK_TKT
          { const int* ip = INV + ((size_t)(b * NE + e)) * SEQ + (row0 & (SEQ - 1)) + rr; sl0 = ip[0]; sl1 = ip[4]; }
#else
          sl0 = INV[(size_t)(row0 + rr) * NE + e]; sl1 = INV[(size_t)(row0 + 4 + rr) * NE + e];
#endif
          gv0 = sl0 >= 0 ? GV[(size_t)(e * NB + b) * CAP + sl0] : 0.f; gv1 = sl1 >= 0 ? GV[(size_t)(e * NB + b) * CAP + sl1] : 0.f; }
        const unsigned long long mk0 = __ballot(sl0 >= 0), mk1 = __ballot(sl1 >= 0);
        const int gi0 = __builtin_bit_cast(int, gv0), gi1 = __builtin_bit_cast(int, gv1);
        Row16 g2, gs, sh; ld_f32(g2, mm + 5 * 1024, F.lane); ld_f32(gs, gnext, F.lane);
        if (!FINAL) { const float* mn = modnext + (size_t)b * NMOD6; Row16 tmp; ld_f32(tmp, mn + 1024, F.lane); ld_f32(sh, mn, F.lane);
#pragma unroll
            for (int jj = 0; jj < 2; ++jj)
#pragma unroll
                for (int hf = 0; hf < 2; ++hf) gs.a[jj][hf] = gs.a[jj][hf] * (tmp.a[jj][hf] + 1.0f); }
#pragma unroll
        for (int hh = 0; hh < 2; ++hh) {
        v4u ya[8][2], yb[8][2], hw[8][2]; float ga[8], gb[8]; unsigned rest[8];
#pragma unroll
        for (int r = 4 * hh; r < 4 * hh + 4; ++r)
#pragma unroll
            for (int jj = 0; jj < 2; ++jj) hw[r][jj] = ((const v4u*)(Hb + (size_t)(row0 + r) * DM))[F.lane + 64 * jj];
#pragma unroll
        for (int r = 4 * hh; r < 4 * hh + 4; ++r) { const int slv = r < 4 ? sl0 : sl1, giv = r < 4 ? gi0 : gi1, lb = (r & 3) * 16;
            unsigned mask = (unsigned)(((r < 4 ? mk0 : mk1) >> lb) & 0xFFFFull);
            const bool one = mask != 0u; const int ea = one ? __builtin_ctz(mask) : 0; if (one) mask &= mask - 1; const bool two = mask != 0u; const int eb = two ? __builtin_ctz(mask) : ea; if (two) mask &= mask - 1;
            rest[r] = mask;
            const int sa = __builtin_amdgcn_readlane(slv, lb + ea), sb = __builtin_amdgcn_readlane(slv, lb + eb);
            ga[r] = one ? __builtin_bit_cast(float, __builtin_amdgcn_readlane(giv, lb + ea)) : 0.f; gb[r] = two ? __builtin_bit_cast(float, __builtin_amdgcn_readlane(giv, lb + eb)) : 0.f;
            const bf16* pa = Y + ((size_t)(ea * NB + b) * CAP + (one ? sa : 0)) * DM; const bf16* pb = Y + ((size_t)(eb * NB + b) * CAP + (one ? sb : 0)) * DM;
#pragma unroll
            for (int jj = 0; jj < 2; ++jj) { ya[r][jj] = ((const v4u*)pa)[F.lane + 64 * jj]; yb[r][jj] = ((const v4u*)pb)[F.lane + 64 * jj]; } }
        asm volatile("" ::: "memory");
#if MK_COMB4
        Row16 h4[4];
#pragma unroll
        for (int k = 0; k < 4; ++k) { const int r = 4 * hh + k; Row16 acc, t; un_bf16(h4[k], hw[r]); un_bf16(acc, ya[r]); un_bf16(t, yb[r]);
#pragma unroll
            for (int jj = 0; jj < 2; ++jj)
#pragma unroll
                for (int hf = 0; hf < 2; ++hf) h4[k].a[jj][hf] += g2.a[jj][hf] * (acc.a[jj][hf] * ga[r] + t.a[jj][hf] * gb[r]); }
        if ((rest[4 * hh] | rest[4 * hh + 1] | rest[4 * hh + 2] | rest[4 * hh + 3]) != 0u) {
            v4u yc[4][2], yd[4][2]; float gc4[4], gd4[4]; bool has3[4], has4[4];
#pragma unroll
            for (int k = 0; k < 4; ++k) { const int r = 4 * hh + k; const int slv = r < 4 ? sl0 : sl1, giv = r < 4 ? gi0 : gi1, lb = (r & 3) * 16; unsigned mask = rest[r];
                const bool three = mask != 0u; const int ec = three ? __builtin_ctz(mask) : 0; if (three) mask &= mask - 1; const bool four = mask != 0u; const int ed = four ? __builtin_ctz(mask) : ec; if (four) mask &= mask - 1;
                rest[r] = mask; has3[k] = three; has4[k] = four; gc4[k] = 0.f; gd4[k] = 0.f;
#pragma unroll
                for (int jj = 0; jj < 2; ++jj) { yc[k][jj] = (v4u){0u, 0u, 0u, 0u}; yd[k][jj] = (v4u){0u, 0u, 0u, 0u}; }
                if (three) { const int sc = __builtin_amdgcn_readlane(slv, lb + ec); gc4[k] = __builtin_bit_cast(float, __builtin_amdgcn_readlane(giv, lb + ec));
                    const bf16* pc = Y + ((size_t)(ec * NB + b) * CAP + sc) * DM;
#pragma unroll
                    for (int jj = 0; jj < 2; ++jj) yc[k][jj] = ((const v4u*)pc)[F.lane + 64 * jj]; }
                if (four) { const int sd = __builtin_amdgcn_readlane(slv, lb + ed); gd4[k] = __builtin_bit_cast(float, __builtin_amdgcn_readlane(giv, lb + ed));
                    const bf16* pd = Y + ((size_t)(ed * NB + b) * CAP + sd) * DM;
#pragma unroll
                    for (int jj = 0; jj < 2; ++jj) yd[k][jj] = ((const v4u*)pd)[F.lane + 64 * jj]; } }
            asm volatile("" ::: "memory");
#pragma unroll
            for (int k = 0; k < 4; ++k) { const int r = 4 * hh + k; Row16 acc, t; un_bf16(acc, yc[k]); un_bf16(t, yd[k]);
#pragma unroll
                for (int jj = 0; jj < 2; ++jj)
#pragma unroll
                    for (int hf = 0; hf < 2; ++hf) h4[k].a[jj][hf] += g2.a[jj][hf] * (acc.a[jj][hf] * gc4[k] + t.a[jj][hf] * gd4[k]);
                unsigned mask = rest[r];
                if (mask) { const int slv = r < 4 ? sl0 : sl1, giv = r < 4 ? gi0 : gi1, lb = (r & 3) * 16;
                    while (mask) {
                        const int ec = __builtin_ctz(mask); mask &= mask - 1;
                        const int sc = __builtin_amdgcn_readlane(slv, lb + ec); const float gc = __builtin_bit_cast(float, __builtin_amdgcn_readlane(giv, lb + ec));
                        const bf16* pc = Y + ((size_t)(ec * NB + b) * CAP + sc) * DM; v4u ye[2];
#pragma unroll
                        for (int jj = 0; jj < 2; ++jj) ye[jj] = ((const v4u*)pc)[F.lane + 64 * jj];
                        un_bf16(t, ye);
#pragma unroll
                        for (int jj = 0; jj < 2; ++jj)
#pragma unroll
                            for (int hf = 0; hf < 2; ++hf) h4[k].a[jj][hf] += g2.a[jj][hf] * (t.a[jj][hf] * gc); } } }
        }
#pragma unroll
        for (int k = 0; k < 4; ++k) { const int row = row0 + 4 * hh + k; Row16& h = h4[k];
            const float rstd = __builtin_amdgcn_rsqf(wave_sum(sumsq(h), F.lane) * (1.f / DM) + EPSN);
            if (FINAL) {
#pragma unroll
                for (int jj = 0; jj < 2; ++jj)
#pragma unroll
                    for (int hf = 0; hf < 2; ++hf) ((f32x4*)(out + (size_t)row * DM))[2 * (F.lane + 64 * jj) + hf] = h.a[jj][hf] * rstd * gs.a[jj][hf];
            } else { st_bf16(Hb + (size_t)row * DM, F.lane, h); Row16 o;
#pragma unroll
                for (int jj = 0; jj < 2; ++jj)
#pragma unroll
                    for (int hf = 0; hf < 2; ++hf) o.a[jj][hf] = h.a[jj][hf] * rstd * gs.a[jj][hf] + sh.a[jj][hf];
                st_bf16(XN + (size_t)row * DM, F.lane, o); }
        }
#else
#pragma unroll
        for (int r = 4 * hh; r < 4 * hh + 4; ++r) { const int row = row0 + r; Row16 h, acc, t; un_bf16(h, hw[r]);
            un_bf16(acc, ya[r]); un_bf16(t, yb[r]);
#pragma unroll
            for (int jj = 0; jj < 2; ++jj)
#pragma unroll
                for (int hf = 0; hf < 2; ++hf) acc.a[jj][hf] = acc.a[jj][hf] * ga[r] + t.a[jj][hf] * gb[r];
            unsigned mask = rest[r];
            if (mask) { const int slv = r < 4 ? sl0 : sl1, giv = r < 4 ? gi0 : gi1, lb = (r & 3) * 16;
                while (mask) {
                    const int ec = __builtin_ctz(mask); mask &= mask - 1;
                    const int sc = __builtin_amdgcn_readlane(slv, lb + ec); const float gc = __builtin_bit_cast(float, __builtin_amdgcn_readlane(giv, lb + ec));
                    const bf16* pc = Y + ((size_t)(ec * NB + b) * CAP + sc) * DM; v4u yc[2];
#pragma unroll
                    for (int jj = 0; jj < 2; ++jj) yc[jj] = ((const v4u*)pc)[F.lane + 64 * jj];
                    un_bf16(t, yc);
#pragma unroll
                    for (int jj = 0; jj < 2; ++jj)
#pragma unroll
                        for (int hf = 0; hf < 2; ++hf) acc.a[jj][hf] += t.a[jj][hf] * gc; } }
#pragma unroll
            for (int jj = 0; jj < 2; ++jj)
#pragma unroll
                for (int hf = 0; hf < 2; ++hf) h.a[jj][hf] += g2.a[jj][hf] * acc.a[jj][hf];
            const float rstd = __builtin_amdgcn_rsqf(wave_sum(sumsq(h), F.lane) * (1.f / DM) + EPSN);
            if (FINAL) {
#pragma unroll
                for (int jj = 0; jj < 2; ++jj)
#pragma unroll
                    for (int hf = 0; hf < 2; ++hf) ((f32x4*)(out + (size_t)row * DM))[2 * (F.lane + 64 * jj) + hf] = h.a[jj][hf] * rstd * gs.a[jj][hf];
            } else { st_bf16(Hb + (size_t)row * DM, F.lane, h); Row16 o;
#pragma unroll
                for (int jj = 0; jj < 2; ++jj)
#pragma unroll
                    for (int hf = 0; hf < 2; ++hf) o.a[jj][hf] = h.a[jj][hf] * rstd * gs.a[jj][hf] + sh.a[jj][hf];
                st_bf16(XN + (size_t)row * DM, F.lane, o); }
        }
#endif
        }
    }
}

__device__ __forceinline__ void phase_sconv(const Ctx& F0, const float* w) {
    const Ctx F = fresh(F0);
    const bf16* BG = (const bf16*)(F.ws + WS_RA + RA_BG); const bf16* CX = (const bf16*)(F.ws + WS_RA + RA_CX); bf16* Z = (bf16*)(F.ws + WS_HID);
    const int gw = F.vcu * NWAVES + F.wave, NGW = F.G * NWAVES;
    const v4u zero4 = (v4u){0u, 0u, 0u, 0u};
    for (int grp = gw; grp < 2048; grp += NGW) {
        const int row0 = grp * 8, t0 = row0 & (SEQ - 1); int ln = F.lane; asm volatile("" : "+v"(ln));
        v4u cx[10][2], bg[8][2];
#pragma unroll
        for (int r = 0; r < 10; ++r) { const bool ok = (t0 + r - 1) >= 0 && (t0 + r - 1) < SEQ;
#pragma unroll
            for (int jj = 0; jj < 2; ++jj) cx[r][jj] = ok ? ((const v4u*)(CX + (size_t)(row0 + r - 1) * DM))[ln + 64 * jj] : zero4; }
#pragma unroll
        for (int r = 0; r < 8; ++r)
#pragma unroll
            for (int jj = 0; jj < 2; ++jj) bg[r][jj] = ((const v4u*)(BG + (size_t)(row0 + r) * DM))[ln + 64 * jj];
        Row16 wk[3];
#pragma unroll
        for (int k = 0; k < 3; ++k) ld_f32(wk[k], w + k * DM, ln);
        asm volatile("" ::: "memory");
#pragma unroll
        for (int r = 0; r < 8; ++r) { Row16 p, c, n, g, o; un_bf16(p, cx[r]); un_bf16(c, cx[r + 1]); un_bf16(n, cx[r + 2]); un_bf16(g, bg[r]);
#pragma unroll
            for (int jj = 0; jj < 2; ++jj)
#pragma unroll
                for (int hf = 0; hf < 2; ++hf) o.a[jj][hf] = g.a[jj][hf] * (wk[0].a[jj][hf] * p.a[jj][hf] + wk[1].a[jj][hf] * c.a[jj][hf] + wk[2].a[jj][hf] * n.a[jj][hf]);
            st_bf16(Z + (size_t)(row0 + r) * DM, ln, o); }
    }
}

__device__ __forceinline__ void conv_unit(const Ctx& F0, int unit, const float* cw, const float* cb, const float* lg, const float* lb) {
    const Ctx F = fresh(F0);
    const bf16* G = (const bf16*)(F.ws + WS_RA + RA_G); bf16* ZO = (bf16*)(F.ws + WS_RA + RA_ZO);
    LAS unsigned char* IN = F.lds; LAS float* OUT = (LAS float*)(F.lds + 63488);
    const int row0 = unit * 32, b = row0 >> 12, t0 = row0 & (SEQ - 1);
#pragma unroll
    for (int k = 0; k < 8; ++k) { const int ch = F.tid + 512 * k; if (ch < 62 * 64) { const int r = ch >> 6, c16 = ch & 63, tt = t0 - 15 + r;
        v4u val = (v4u){0u, 0u, 0u, 0u}; if (tt >= 0 && tt < SEQ) val = *(const v4u*)(G + ((size_t)b * SEQ + tt) * 512 + c16 * 8);
        *(LAS v4u*)(IN + r * 1024 + c16 * 16) = val; } }
    __syncthreads();
    { const int cp = F.tid & 255, rh = F.tid >> 8;
      typedef float f32x2 __attribute__((ext_vector_type(2)));
      f32x2 wv[31];
#pragma unroll
      for (int k = 0; k < 31; ++k) wv[k] = *(const f32x2*)(cw + k * 512 + 2 * cp);
      const f32x2 bias = *(const f32x2*)(cb + 2 * cp);
      f32x2 a[16];
#pragma unroll
      for (int r = 0; r < 16; ++r) a[r] = bias;
#pragma unroll
      for (int j = 0; j < 46; ++j) { const unsigned wd = *(const LAS unsigned*)(IN + (16 * rh + j) * 1024 + cp * 4); const f32x2 x = (f32x2){bf_lo(wd), bf_hi(wd)};
#pragma unroll
          for (int r = 0; r < 16; ++r) { if (j - r >= 0 && j - r < 31) a[r] += x * wv[j - r]; } }
#pragma unroll
      for (int r = 0; r < 16; ++r) *(LAS f32x2*)(OUT + (16 * rh + r) * 512 + 2 * cp) = a[r]; }
    __syncthreads();
    { f32x4 lgv[2], lbv[2];
#pragma unroll
      for (int j = 0; j < 2; ++j) { lgv[j] = ((const f32x4*)lg)[F.lane + 64 * j]; lbv[j] = ((const f32x4*)lb)[F.lane + 64 * j]; }
#pragma unroll
      for (int rr = 0; rr < 4; ++rr) { const int r = F.wave * 4 + rr; f32x4 x[2];
#pragma unroll
          for (int j = 0; j < 2; ++j) x[j] = ((const LAS f32x4*)(OUT + r * 512))[F.lane + 64 * j];
          const float mu = wave_sum(sum4(x[0]) + sum4(x[1]), F.lane) * (1.f / 512.f);
          x[0] = x[0] - mu; x[1] = x[1] - mu;
          const float rstd = __builtin_amdgcn_rsqf(wave_sum(dot4(x[0], x[0]) + dot4(x[1], x[1]), F.lane) * (1.f / 512.f) + EPSN);
#pragma unroll
          for (int j = 0; j < 2; ++j) { f32x4 y = x[j] * rstd * lgv[j] + lbv[j];
#pragma unroll
              for (int i = 0; i < 4; ++i) y[i] = y[i] * pg8::fast_sigmoid(y[i]);
              ((u32x2*)(ZO + (size_t)(row0 + r) * DM + 512))[F.lane + 64 * j] = pack4(y); } } }
    __syncthreads();
}

__device__ __forceinline__ void conv_units(const Ctx& F0, int unit0, int n, const float* cw, const float* cb, const float* lg, const float* lb) {
    const Ctx F = fresh(F0);
    const bf16* G = (const bf16*)(F.ws + WS_RA + RA_G); bf16* ZO = (bf16*)(F.ws + WS_RA + RA_ZO);
    LAS unsigned char* IN = F.lds; LAS float* OUT = (LAS float*)(F.lds + 63488);
    typedef float f32x2 __attribute__((ext_vector_type(2)));
    const int cp = F.tid & 255, rh = F.tid >> 8;
    v4u pre[8];
#define CU_FETCH(u) do { const int row0_ = (u) * 32, b_ = row0_ >> 12, t0_ = row0_ & (SEQ - 1); \
        _Pragma("unroll") for (int k = 0; k < 8; ++k) { const int ch = F.tid + 512 * k; pre[k] = (v4u){0u, 0u, 0u, 0u}; if (ch < 62 * 64) { const int r = ch >> 6, c16 = ch & 63, tt = t0_ - 15 + r; \
            if (tt >= 0 && tt < SEQ) pre[k] = *(const v4u*)(G + ((size_t)b_ * SEQ + tt) * 512 + c16 * 8); } } } while (0)
#define CU_STAGE() do { _Pragma("unroll") for (int k = 0; k < 8; ++k) { const int ch = F.tid + 512 * k; if (ch < 62 * 64) *(LAS v4u*)(IN + (ch >> 6) * 1024 + (ch & 63) * 16) = pre[k]; } } while (0)
    CU_FETCH(unit0);
    f32x2 wv[31];
#pragma unroll
    for (int k = 0; k < 31; ++k) wv[k] = *(const f32x2*)(cw + k * 512 + 2 * cp);
    const f32x2 bias = *(const f32x2*)(cb + 2 * cp);
    f32x4 lgv[2], lbv[2];
#pragma unroll
    for (int j = 0; j < 2; ++j) { lgv[j] = ((const f32x4*)lg)[F.lane + 64 * j]; lbv[j] = ((const f32x4*)lb)[F.lane + 64 * j]; }
    for (int i = 0; i < n; ++i) {
        const int row0 = (unit0 + i) * 32;
        CU_STAGE();
        __syncthreads();
        if (i + 1 < n) CU_FETCH(unit0 + i + 1);
        { f32x2 a[16];
#pragma unroll
          for (int r = 0; r < 16; ++r) a[r] = bias;
#pragma unroll
          for (int j = 0; j < 46; ++j) { const unsigned wd = *(const LAS unsigned*)(IN + (16 * rh + j) * 1024 + cp * 4); const f32x2 x = (f32x2){bf_lo(wd), bf_hi(wd)};
#pragma unroll
              for (int r = 0; r < 16; ++r) { if (j - r >= 0 && j - r < 31) a[r] += x * wv[j - r]; } }
#pragma unroll
          for (int r = 0; r < 16; ++r) *(LAS f32x2*)(OUT + (16 * rh + r) * 512 + 2 * cp) = a[r]; }
        __syncthreads();
#pragma unroll
        for (int rr = 0; rr < 4; ++rr) { const int r = F.wave * 4 + rr; f32x4 x[2];
#pragma unroll
            for (int j = 0; j < 2; ++j) x[j] = ((const LAS f32x4*)(OUT + r * 512))[F.lane + 64 * j];
            const float mu = wave_sum(sum4(x[0]) + sum4(x[1]), F.lane) * (1.f / 512.f);
            x[0] = x[0] - mu; x[1] = x[1] - mu;
            const float rstd = __builtin_amdgcn_rsqf(wave_sum(dot4(x[0], x[0]) + dot4(x[1], x[1]), F.lane) * (1.f / 512.f) + EPSN);
#pragma unroll
            for (int j = 0; j < 2; ++j) { f32x4 y = x[j] * rstd * lgv[j] + lbv[j];
#pragma unroll
                for (int q = 0; q < 4; ++q) y[q] = y[q] * pg8::fast_sigmoid(y[q]);
                ((u32x2*)(ZO + (size_t)(row0 + r) * DM + 512))[F.lane + 64 * j] = pack4(y); } }
        __syncthreads();
    }
#undef CU_FETCH
#undef CU_STAGE
}

struct Args { const float* in[24]; float* out; unsigned char* ws; int ph_lo, ph_hi; };
typedef const Args __attribute__((address_space(4))) CArgs;
#define FRESH_ARGS() ({ CArgs* a_ = (CArgs*)__builtin_amdgcn_kernarg_segment_ptr(); asm volatile("" : "+s"(a_)); a_; })
__device__ __forceinline__ Ctx make_ctx(unsigned char* lds_raw) {
    Ctx F; F.lds = (LAS unsigned char*)lds_raw;
    { CArgs* a = FRESH_ARGS(); F.ws = a->ws; }
    int t = threadIdx.x; asm volatile("" : "+v"(t));
    F.tid = t; F.lane = t & 63; F.wave = __builtin_amdgcn_readfirstlane(t >> 6);
    F.G = gridDim.x; F.bx = blockIdx.x; F.vcu = (F.G % 8 == 0) ? (F.bx % 8) * (F.G / 8) + F.bx / 8 : F.bx;
    return F;
}
__global__ void __launch_bounds__(NWAVES * 64, 2) mk_fwd(Args args_unused) {
    extern __shared__ __attribute__((aligned(16))) unsigned char lds_raw[];
    { const int t = threadIdx.x; for (int u = t; u < (LDS_BYTES - LDSCTL_OFF) / 4; u += NWAVES * 64) ((LAS unsigned*)((LAS unsigned char*)lds_raw + LDSCTL_OFF))[u] = 0u; }
    __syncthreads();
#if !MK_PER_PHASE
    { CArgs* a = FRESH_ARGS(); (void)xcd_barrier_post((unsigned*)(a->ws + WS_CTL) + CW_BAR, (volatile LAS unsigned*)((LAS unsigned char*)lds_raw + MISC_OFF) + 8); }
#endif
    int lo, hi; { CArgs* a = FRESH_ARGS(); lo = a->ph_lo; hi = a->ph_hi; }
#ifdef MK_SPINTEST
    if (threadIdx.x == 0 && blockIdx.x == 0) { const unsigned long long t0 = rt(); while (rt() - t0 < (unsigned long long)(MK_SPINTEST)) __builtin_amdgcn_s_sleep(8); }
    __syncthreads();
#endif
#if MK_TPROBE
    if (threadIdx.x == 0 && blockIdx.x == 0) { CArgs* a = FRESH_ARGS(); unsigned long long* TSW = (unsigned long long*)(a->ws + WS_CTL + 131072); const unsigned long long now = rt();
#if MK_TPROBE == 2
        unsigned long long mx = 0ull; for (int i = 0; i < 256; ++i) { const unsigned long long v = __hip_atomic_load(TSW + 17 * 256 + i, RLX_AGENT); mx = v > mx ? v : mx; }
        TSW[18 * 256 + 32] = now - mx;
#endif
        TSW[18 * 256 + 0] = now; }
#endif
#if !MK_PER_PHASE && MK_COOP_MARK
    if (hi > NPHASE) cooperative_groups::this_grid().sync();
#endif
#ifndef MK_PHMASK
#define MK_PHMASK 0x3ffff
#endif
#define PH(k) case k: if (!(((MK_PHMASK) >> (k)) & 1)) break;
#define WSP(T, off) ((T*)(F.ws + (off)))
#ifndef MK_PASSES
#define MK_PASSES 1
#endif
#if MK_PASSES > 1
    for (int it_ = 0; it_ < MK_PASSES * NPHASE; ++it_) { const int pass = it_ / NPHASE, ph = it_ % NPHASE;
#else
    for (int ph = lo; ph < hi; ++ph) { const int pass = 0;
#endif
        const int l = ph >= 13 ? 1 : 0;
        __builtin_amdgcn_s_waitcnt(0);
        const Ctx F = make_ctx(lds_raw); LAS unsigned char* ring = F.lds + RING_OFF;
        switch (ph) {
        PH(0) { CArgs* a = FRESH_ARGS(); phase0(F, a); } break;
        PH(1) { CArgs* a = FRESH_ARGS(); phase_norm1(F, a->in[0], a->in[2], a->in[6], WSP(float, WS_MOD)); } break;
        PH(12) {
            pg8::Gemm g{WSP(bf16, WS_HID)  , WSP(bf16, WS_SCOUT), MTOK, DM, DM, 1 << 30, 0};
            pg8::StaticOrder S; S.init(MTOK, DM, F.G, F.bx);
            pg8::EpiResB<true> E{WSP(bf16, WS_H), WSP(bf16, WS_H), WSP(float, WS_MOD) + (size_t)5 * NMOD6 + 2 * 1024, NMOD6};
            pg8::gemm_phase<pg8::EpiResB<true>, pg8::StaticOrder, false, false>(ring, g, S, E);
        } break;
        PH(2) {
            CArgs* a = FRESH_ARGS();
            pg8::Gemm g{WSP(bf16, WS_XN), WSP(bf16, WS_WIN), MTOK, EIN, DM, 1 << 30, 0};
            pg8::OrderL0 S; S.init(F.G, F.bx);
            pg8::EpiL0 E{WSP(bf16, WS_RA + RA_Q), WSP(bf16, WS_KB), WSP(bf16, WS_VB), WSP(bf16, WS_RA + RA_G), WSP(float, WS_ROPE), WSP(float, WS_ROPE) + SEQ * 32, a->in[9], a->in[10], attn_body::C2};
            pg8::gemm_phase<pg8::EpiL0, pg8::OrderL0, true, false>(ring, g, S, E);
#if MK_BSET
            if (F.bx >= 196 && F.bx < 204) { const int idx = F.bx - 196, l2 = idx >> 2, b2 = idx & 3;
                build_bset(F, a->in[7] + l2 * DM, WSP(float, WS_MOD) + (size_t)l2 * 5 * NMOD6 + (size_t)b2 * NMOD6, a->in[19] + (size_t)l2 * DM * NE, idx); }
#endif
        } break;
        PH(3) {
            CArgs* a = FRESH_ARGS(); const int nchunk = NCHUNK;
            gu32* pool = (gu32*)(a->ws + WS_CTL) + CW_POOL; volatile LAS unsigned* claim = (volatile LAS unsigned*)(F.lds + MISC_OFF) + 16;
#define CLAIM(word, n) ({ __syncthreads(); if (threadIdx.x == 0) claim[0] = __hip_atomic_fetch_add(pool + 64 * (word), (unsigned)(n), RLX_AGENT); __syncthreads(); (int)claim[0]; })
#ifndef MK_CHUNK_REPS
#define MK_CHUNK_REPS 1
#endif
#define CHUNK(c) do { for (int rep_ = 0; rep_ < MK_CHUNK_REPS; ++rep_) { const Ctx Fc = fresh(F); convert_items8d(Fc, a, I_POOL0 + (c) * CHUNK_ITEMS + Fc.wave * 8); } } while (0)
#ifndef MK_SCHED
#define MK_SCHED 0x00C3
#endif
#if defined(MK_RCU_PROBE)
            if ((F.vcu & 15) == 0) { const Ctx Fp = fresh(F); const f32x4* src = (const f32x4*)(a->in[21]) + (size_t)((F.vcu >> 4) * 8 + Fp.wave) * (1024 * 1024 / 16) ; f32x4 acc4 = (f32x4){0.f, 0.f, 0.f, 0.f};
                for (int i = 0; i < 1024 * 1024 / 16 / 64; i += MK_RCU_PROBE) { f32x4 t[MK_RCU_PROBE];
#pragma unroll
                    for (int u = 0; u < MK_RCU_PROBE; ++u) t[u] = src[(size_t)(i + u) * 64 + Fp.lane];
#pragma unroll
                    for (int u = 0; u < MK_RCU_PROBE; ++u) acc4 += t[u]; }
                if (acc4[0] + acc4[1] + acc4[2] + acc4[3] == 1.2345f) ((float*)(F.ws + WS_HID))[Fp.tid] = acc4[0];
                __syncthreads(); }
#endif
#ifndef MK_ROLES
#define MK_ROLES 0
#endif
#if MK_ROLES
#ifndef MK_RA
#define MK_RA 6
#endif
#ifndef MK_RB
#define MK_RB 12
#endif
#ifndef MK_RC
#define MK_RC 19
#endif
#ifndef MK_NCH
#define MK_NCH 5
#endif
#ifndef MK_NCHX
#define MK_NCHX 2
#endif
#ifndef MK_NCV
#define MK_NCV 5
#endif
            const int jx = F.vcu & 31; const bool conv_role = jx >= MK_RC;
            const int slot = conv_role ? (jx - MK_RC) % 3 : (jx < MK_RA ? 0 : jx < MK_RB ? 1 : 2);
            const int nfill = conv_role ? MK_NCV : MK_NCH + (((jx < MK_RA ? jx : jx - MK_RA) < MK_NCHX) ? 1 : 0);
            const int pair = F.vcu >> 5, b = pair >> 1, kvh = pair & 1;
            for (int s = 0; s < 4; ++s) {
                if (s >= 2 || slot == s) {
                    const bool cv = (s == 3) ? !conv_role : conv_role; const int step = s >= 2 ? 1 : nfill, lim = cv ? MTOK / 32 : nchunk;
                    for (;;) { const int i0 = cv ? CLAIM(1, step) : CLAIM(0, step); if (i0 >= lim) break;
                        for (int k = 0; k < step && i0 + k < lim; ++k) { if (cv) conv_unit(F, i0 + k, a->in[11], a->in[12], a->in[13], a->in[14]); else CHUNK(i0 + k); }
                        if (s < 2) break; }
                    __syncthreads();
                }
                if (s < 2) { const int local = (F.vcu & 31) * 2 + s, hq = kvh * 4 + (local >> 4), qb = local & 15;
                    const attn_body::bf16* Qu = WSP(attn_body::bf16, WS_RA + RA_Q) + ((size_t)(b * SEQ + qb * 256) * 512 + hq * 64);
                    const attn_body::bf16* Kh = WSP(attn_body::bf16, WS_KB) + ((size_t)b * TKV * 128 + kvh * 64);
                    const attn_body::bf16* Vh = WSP(attn_body::bf16, WS_VB) + ((size_t)b * TKV * 128 + kvh * 64);
                    attn_body::bf16* Ou = WSP(attn_body::bf16, WS_RA + RA_ZO) + ((size_t)(b * SEQ + qb * 256) * DM + hq * 64);
                    attn_body::attn_unit<8>(Qu, Kh, Vh, Ou, (char*)lds_raw + RING_OFF); }
            }
#else
#ifndef MK_DRAIN_N
#define MK_DRAIN_N 1
#endif
#ifndef MK_SCHED_MOD
#define MK_SCHED_MOD 3
#endif
#ifndef MK_SCHED_ALT
#define MK_SCHED_ALT 0
#endif
            const int sch_r = (F.vcu >> 1) % MK_SCHED_MOD, alt_ = (MK_SCHED_ALT && !(F.vcu & 1)) ? 1 : 0;
            int npre = ((MK_SCHED) >> (4 * sch_r)) & 3, nmid = ((MK_SCHED) >> (4 * sch_r + 2)) & 3; if (npre) npre -= alt_; if (nmid) nmid -= alt_;
            if (npre) { const int c0 = CLAIM(0, npre); for (int i = 0; i < npre && c0 + i < nchunk; ++i) CHUNK(c0 + i); }
            __syncthreads();
            const int pair = F.vcu >> 5, b = pair >> 1, kvh = pair & 1;
            for (int i = 0; i < 2; ++i) { const int local = (F.vcu & 31) * 2 + i, hq = kvh * 4 + (local >> 4), qb = local & 15;
                const attn_body::bf16* Qu = WSP(attn_body::bf16, WS_RA + RA_Q) + ((size_t)(b * SEQ + qb * 256) * 512 + hq * 64);
                const attn_body::bf16* Kh = WSP(attn_body::bf16, WS_KB) + ((size_t)b * TKV * 128 + kvh * 64);
                const attn_body::bf16* Vh = WSP(attn_body::bf16, WS_VB) + ((size_t)b * TKV * 128 + kvh * 64);
                attn_body::bf16* Ou = WSP(attn_body::bf16, WS_RA + RA_ZO) + ((size_t)(b * SEQ + qb * 256) * DM + hq * 64);
                attn_body::attn_unit<8>(Qu, Kh, Vh, Ou, (char*)lds_raw + RING_OFF);
                if (i == 0 && nmid) { const int c0 = CLAIM(0, nmid); for (int k = 0; k < nmid && c0 + k < nchunk; ++k) CHUNK(c0 + k); __syncthreads(); } }
#if MK_TPROBE
            if (threadIdx.x == 0) ((unsigned long long*)(a->ws + WS_CTL + 131072))[20 * 256 + blockIdx.x] = rt();
#endif
            for (;;) { const int c0 = CLAIM(0, MK_DRAIN_N); if (c0 >= nchunk) break; for (int k = 0; k < MK_DRAIN_N && c0 + k < nchunk; ++k) CHUNK(c0 + k); }
            for (;;) { const int u0 = CLAIM(1, 2); if (u0 >= MTOK / 32) break; conv_units(F, u0, (u0 + 2 <= MTOK / 32) ? 2 : 1, a->in[11], a->in[12], a->in[13], a->in[14]); }
#endif
#undef CLAIM
#undef CHUNK
        } break;
        PH(4) {
            CArgs* a = FRESH_ARGS();
#if MK_PASSES > 1
            if (F.bx == 0 && F.tid == 0) { gu32* pool = (gu32*)(a->ws + WS_CTL) + CW_POOL; __hip_atomic_store(pool, 0u, RLX_AGENT); __hip_atomic_store(pool + 64, 0u, RLX_AGENT); }
#endif
            pg8::Gemm g{WSP(bf16, WS_RA + RA_ZO), WSP(bf16, WS_WOUT), MTOK, DM, DM, 1 << 30, 0};
            pg8::StaticOrder S; S.init(MTOK, DM, F.G, F.bx);
            pg8::EpiResB<false> E{a->in[0], WSP(bf16, WS_H), WSP(float, WS_MOD) + 2 * 1024, NMOD6};
            pg8::gemm_phase<pg8::EpiResB<false>, pg8::StaticOrder, false, false>(ring, g, S, E);
        } break;
        case 13: PH(5) { CArgs* a = FRESH_ARGS(); phase_norm2_router(F, a->in[7] + l * DM, WSP(float, WS_MOD) + (size_t)l * 5 * NMOD6, a->in[19] + (size_t)l * DM * NE, l); } break;
        case 14: PH(6) { CArgs* a = FRESH_ARGS(); phase_topk(F, a, l); } break;
        case 15: PH(7) {
            pg8::Gemm g{WSP(bf16, WS_XN), WSP(bf16, WS_GU) + (size_t)l * NE * 2048 * 1024, MR, 2048, DM, 8, (size_t)2048 * 1024 * 2};
            pg8::StaticOrder S; S.init(MR, 2048, F.G, F.bx);
            LAS unsigned* gl = (LAS unsigned*)(F.lds + GL_OFF); const unsigned* GOFF = WSP(unsigned, WS_GOFF);
            { int t = threadIdx.x; asm volatile("" : "+v"(t));
#pragma unroll
              for (int i = 0; i < 4; ++i) { pg8::StaticOrder S2; S2.init(MR, 2048, F.G, F.bx); pg8::Unit u; if (S2.next(i, u) && t < 256) gl[i * 256 + t] = GOFF[u.pm * 256 + t]; } }
            __syncthreads();
            pg8::EpiPair<1> E{WSP(bf16, WS_HID), 1024, 0, nullptr, 0};
            pg8::gemm_phase<pg8::EpiPair<1>, pg8::StaticOrder, true, true>(ring, g, S, E, gl);
        } break;
        case 16: PH(8) {
            pg8::Gemm g{WSP(bf16, WS_HID), WSP(bf16, WS_DN) + (size_t)l * NE * 1024 * 1024, MR, DM, 1024, 8, (size_t)1024 * 1024 * 2};
            pg8::StaticOrder S; S.init(MR, DM, F.G, F.bx);
            pg8::EpiBf16 E{WSP(bf16, WS_RA + RA_Y), 1024};
            pg8::gemm_phase<pg8::EpiBf16, pg8::StaticOrder, true, false>(ring, g, S, E);
        } break;
        PH(9) { CArgs* a = FRESH_ARGS(); phase_combine<false>(F, WSP(float, WS_MOD), a->in[6] + DM, WSP(float, WS_MOD) + (size_t)5 * NMOD6, nullptr); } break;
        PH(10) {
            pg8::Gemm g{WSP(bf16, WS_XN), WSP(bf16, WS_SCIN), MTOK, 3072, DM, 1 << 30, 0};
            pg8::StaticOrder S; S.init(MTOK, 3072, F.G, F.bx);
            pg8::EpiPair<2> E{WSP(bf16, WS_RA + RA_CX), 1024, 4, WSP(bf16, WS_RA + RA_BG), 1024};
            pg8::gemm_phase<pg8::EpiPair<2>, pg8::StaticOrder, true, false>(ring, g, S, E);
        } break;
        PH(11) { CArgs* a = FRESH_ARGS(); phase_sconv(F, a->in[17]); } break;
        PH(17) { CArgs* a = FRESH_ARGS(); phase_combine<true>(F, WSP(float, WS_MOD) + (size_t)5 * NMOD6, a->in[23], nullptr, a->out); } break;
        default: break;
        }
#if !MK_PER_PHASE
#if MK_TPROBE
        if (threadIdx.x == 0) { CArgs* a = FRESH_ARGS(); ((unsigned long long*)(a->ws + WS_CTL + 131072))[ph * 256 + blockIdx.x] = rt(); }
#endif
        if (ph + 1 < hi || MK_TPROBE || pass + 1 < MK_PASSES) { CArgs* a = FRESH_ARGS(); XcdBarrier bar; bar.bar = (unsigned*)(a->ws + WS_CTL) + CW_BAR; bar.x = xb_xcc_id(); bar.st = (volatile LAS unsigned*)((LAS unsigned char*)lds_raw + MISC_OFF) + 8;
            if (ph >= BF_SEAM0 && ph < BF_SEAM0 + BF_NSEAM && lo == 0 && hi == NPHASE) {
                const int seam = ph - BF_SEAM0;
                xcd_barrier_fill(bar, [&]() { const Ctx Fb = make_ctx(lds_raw); convert_item1(Fb, a, I_SMALL + I_MOE - BF_ITEMS + (seam * 256 + Fb.bx) * 7 + (Fb.wave - 1)); });
            } else xcd_barrier(bar);
#if MK_TPROBE
            if (threadIdx.x == 0 && blockIdx.x == 0) ((unsigned long long*)(a->ws + WS_CTL + 131072))[18 * 256 + ph + 1] = rt();
#endif
        }
#endif
    }
#if MK_TPROBE
    if (blockIdx.x == 0) { CArgs* a = FRESH_ARGS(); const unsigned long long* TS = (const unsigned long long*)(a->ws + WS_CTL + 131072);
        volatile LAS float* tmp = (volatile LAS float*)((LAS unsigned char*)lds_raw + RING_OFF);
        int t = threadIdx.x; asm volatile("" : "+v"(t));
        float Q = 0.f;
        for (int k = 0; k < 18; ++k) { if (!(((MK_TP_MASK) >> k) & 1)) continue;
            const unsigned long long s0 = TS[18 * 256 + k];
            __syncthreads(); if (t < 256) tmp[t] = (float)(long long)(TS[(MK_TP_ARR >= 0 ? MK_TP_ARR : k) * 256 + t] - s0); __syncthreads();
            if (t == 0) { float mn = 1e30f, mx = -1e30f, sm = 0.f; for (int i = 0; i < 256; ++i) { const float v = tmp[i]; mn = fminf(mn, v); mx = fmaxf(mx, v); sm += v; }
                const float nxt = (float)(long long)(TS[18 * 256 + k + 1] - s0);
                const float ev[5] = {0.f, mn, sm * (1.f / 256.f), mx, nxt};
                Q += ev[MK_TP_X] - ev[MK_TP_Y]; } }
#if MK_TPROBE == 2
        if (t == 0) Q = (float)(long long)TS[18 * 256 + 32];
#endif
        if (t == 0) { float V = 64.f * (Q * 0.01f - (float)(MK_TP_T0)) / (float)(MK_TP_FS); V = fminf(fmaxf(V, 0.f), 64.f); a->out[0] += V; } }
#endif
#undef PH
#undef WSP
}

#ifdef MK_ZERO_KERNEL
__global__ void mk_zero(v4u* p) { p[blockIdx.x * 256 + threadIdx.x] = (v4u){0u, 0u, 0u, 0u}; }
#endif
static void mk_launch(void* const* d_in, const int* in_sizes, int n_in, void* d_out, int out_size, void* d_ws, size_t ws_size, hipStream_t stream) {
    static int grid = 0;
    if (grid == 0) {
        if (n_in != 24 || in_sizes[0] != MTOK * DM || out_size != MTOK * DM || ws_size < WS_END) { fprintf(stderr, "kernel_launch: unexpected shapes / workspace (n_in %d, ws %zu, need %zu)\n", n_in, ws_size, (size_t)WS_END); grid = -1; return; }
        int dev = 0, cus = 0, per_cu = 0;
        if (hipGetDevice(&dev) != hipSuccess || hipDeviceGetAttribute(&cus, hipDeviceAttributeMultiprocessorCount, dev) != hipSuccess) { grid = -1; return; }
        if (hipFuncSetAttribute((const void*)mk_fwd, hipFuncAttributeMaxDynamicSharedMemorySize, LDS_BYTES) != hipSuccess) { fprintf(stderr, "kernel_launch: hipFuncSetAttribute failed\n"); grid = -1; return; }
        if (hipOccupancyMaxActiveBlocksPerMultiprocessor(&per_cu, (const void*)mk_fwd, NWAVES * 64, LDS_BYTES) != hipSuccess || per_cu < 1) { fprintf(stderr, "kernel_launch: occupancy query says %d blocks per CU\n", per_cu); (void)hipGetLastError(); grid = -1; return; }
        if (cus < 256) { fprintf(stderr, "kernel_launch: %d CUs, this kernel needs 256 co-resident workgroups\n", cus); grid = -1; return; }
        grid = 256;
    }
    if (grid < 0) return;
#ifdef MK_ZERO_KERNEL
    hipLaunchKernelGGL(mk_zero, dim3(CTL_ZERO_BYTES / 16 / 256), dim3(256), 0, stream, (v4u*)((char*)d_ws + WS_CTL));
#else
    if (hipMemsetAsync((char*)d_ws + WS_CTL, 0, CTL_ZERO_BYTES, stream) != hipSuccess) { fprintf(stderr, "kernel_launch: memset failed\n"); return; }
#endif
    Args a; memset(&a, 0, sizeof(a));
    for (int i = 0; i < 24; ++i) a.in[i] = (const float*)d_in[i];
    a.out = (float*)d_out; a.ws = (unsigned char*)d_ws;
#if MK_PER_PHASE
#ifndef MK_DUP_MASK
#define MK_DUP_MASK 0
#endif
    for (int p = 0; p < MK_PH_END; ++p) { a.ph_lo = p; a.ph_hi = p + 1; const int reps = ((MK_DUP_MASK >> p) & 1) ? 2 : 1;
        for (int r = 0; r < reps; ++r) hipLaunchKernelGGL(mk_fwd, dim3(grid), dim3(NWAVES * 64), LDS_BYTES, stream, a); }
#else
    a.ph_lo = 0; a.ph_hi = MK_PH_END;
    void* kargs[] = {&a};
    hipError_t e = hipLaunchCooperativeKernel((const void*)mk_fwd, dim3(grid), dim3(NWAVES * 64), kargs, LDS_BYTES, stream);
    if (e != hipSuccess) fprintf(stderr, "kernel_launch: cooperative launch failed: %s\n", hipGetErrorString(e));
#endif
}

#ifndef MK_DEBUG
extern "C" void kernel_launch(void* const* d_in, const int* in_sizes, int n_in, void* d_out, int out_size, void* d_ws, size_t ws_size, hipStream_t stream) {
    mk_launch(d_in, in_sizes, n_in, d_out, out_size, d_ws, ws_size, stream);
#ifdef MK_TWICE
    mk_launch(d_in, in_sizes, n_in, d_out, out_size, d_ws, ws_size, stream);
#endif
}
#endif
```
